# Optimizing an MI355X kernel written in HIP

```python
import math, functools
import jax, jax.numpy as jnp
from jax import lax
import numpy as np

D_MODEL = 2048
BATCH = 1
SEQ = 8192
DEPTH = 2
DEC_BATCH = 32
DEC_SEQ = 16
PAST_LEN = 4096

CHUNK = 64
WINDOW = 128
WIN_CHUNKS = WINDOW // CHUNK
ATT_HEAD_DIM = 64
ATT_HEADS = D_MODEL // 128
ATT_KV_HEADS = ATT_HEADS // 4
ATT_GROUP = ATT_HEADS // ATT_KV_HEADS
ATT_WIDTH = ATT_HEADS * ATT_HEAD_DIM
KV_WIDTH = ATT_KV_HEADS * ATT_HEAD_DIM
RET_HEAD_DIM = 128
RET_HEADS = D_MODEL // 256
RET_WIDTH = RET_HEADS * RET_HEAD_DIM
MIX_WIDTH = ATT_WIDTH + RET_WIDTH
IN_WIDTH = ATT_WIDTH + 2 * KV_WIDTH + 4 * RET_WIDTH
SPLITS = [ATT_WIDTH, ATT_WIDTH + KV_WIDTH, ATT_WIDTH + 2 * KV_WIDTH,
          ATT_WIDTH + 2 * KV_WIDTH + RET_WIDTH, ATT_WIDTH + 2 * KV_WIDTH + 2 * RET_WIDTH,
          ATT_WIDTH + 2 * KV_WIDTH + 3 * RET_WIDTH]
D_FF = 4 * D_MODEL
PLE_DIM = 256
N_BUCKETS = 32
MAX_DISTANCE = 128
ROPE_BASE = 10000.0
EPS = 1e-6
ATT_SCALE = ATT_HEAD_DIM ** -0.5
RET_SCALE = RET_HEAD_DIM ** -0.5

kernel_name = "hybrid_swa_sink_retention_stream_step"


def rmsnorm(x, g):
    xf = x.astype(jnp.float32)
    y = xf * lax.rsqrt(jnp.mean(xf * xf, axis=-1, keepdims=True) + EPS)
    return (y * g.astype(jnp.float32)).astype(x.dtype)


def t5_bucket(rel):
    nb = N_BUCKETS // 2
    max_exact = nb // 2
    ret = jnp.where(rel > 0, nb, 0)
    n = jnp.abs(rel)
    nf = jnp.maximum(n, max_exact).astype(jnp.float32)
    large = max_exact + (jnp.log(nf / max_exact) / math.log(MAX_DISTANCE / max_exact)
                         * (nb - max_exact)).astype(jnp.int32)
    large = jnp.minimum(large, nb - 1)
    return ret + jnp.where(n < max_exact, n, large)


def rel_bias_heads(table, rel):
    b = table[t5_bucket(rel)].astype(jnp.float32)
    q_len, k_len = rel.shape
    return jnp.transpose(b, (2, 0, 1)).reshape(ATT_KV_HEADS, ATT_GROUP, q_len, k_len)


def rotary(x, pos):
    half = x.shape[-1] // 2
    inv = ROPE_BASE ** (-jnp.arange(half, dtype=jnp.float32) / half)
    ang = pos.astype(jnp.float32)[:, None] * inv[None, :]
    cos = jnp.cos(ang)[None, :, None, :]
    sin = jnp.sin(ang)[None, :, None, :]
    x1, x2 = x[..., :half], x[..., half:]
    return jnp.concatenate([x1 * cos - x2 * sin, x2 * cos + x1 * sin], axis=-1)


def sink_attention(q, k, v, bias, sink, mask):
    s = jnp.einsum('...qkgd,...skd->...kgqs', q, k, preferred_element_type=jnp.float32) * ATT_SCALE
    s = s + bias
    if mask is not None:
        s = jnp.where(mask, s, -jnp.inf)
    sk = sink.astype(jnp.float32).reshape(ATT_KV_HEADS, ATT_GROUP, 1, 1)
    m = jnp.maximum(jnp.max(s, axis=-1, keepdims=True), sk)
    pr = jnp.exp(s - m)
    den = jnp.sum(pr, axis=-1, keepdims=True) + jnp.exp(sk - m)
    pr = (pr / den).astype(v.dtype)
    return jnp.einsum('...kgqs,...skd->...qkgd', pr, v)


def band(x):
    b, s = x.shape[:2]
    nc = s // CHUNK
    xp = jnp.pad(x, ((0, 0), (WINDOW, 0), (0, 0), (0, 0)))
    xp = xp.reshape(b, nc + WIN_CHUNKS, CHUNK, ATT_KV_HEADS, ATT_HEAD_DIM)
    return jnp.concatenate([xp[:, j:j + nc] for j in range(WIN_CHUNKS + 1)], axis=2)


def attend_prompt(q, k, v, sink, *, bias, mask):
    b, s = q.shape[:2]
    nc = s // CHUNK
    qc = q.reshape(b, nc, CHUNK, ATT_KV_HEADS, ATT_GROUP, ATT_HEAD_DIM)
    o = sink_attention(qc, band(k), band(v), bias, sink, mask)
    return o.reshape(b, s, ATT_WIDTH), (k[:, -WINDOW:], v[:, -WINDOW:])


def attend_sample(q, k, v, sink, *, bias, cache_k, cache_v):
    b, l = q.shape[:2]
    kk = jnp.concatenate([cache_k.astype(k.dtype), k], axis=1)
    vv = jnp.concatenate([cache_v.astype(v.dtype), v], axis=1)
    o = sink_attention(q, kk, vv, bias, sink, None)
    return o.reshape(b, l, ATT_WIDTH), (k, v)


def log_gamma():
    return jnp.log(1.0 - 2.0 ** (-5.0 - jnp.arange(RET_HEADS, dtype=jnp.float32)))


def retention(q, k, v, g, gain, pos, state0, chunk):
    b, l = q.shape[:2]
    nc = l // chunk
    f32 = jnp.float32
    shp = (b, l, RET_HEADS, RET_HEAD_DIM)
    q = rotary(q.reshape(shp).astype(f32), pos)
    k = rotary(k.reshape(shp).astype(f32), pos) * RET_SCALE
    v = v.reshape(shp).astype(f32)
    cshp = (b, nc, chunk, RET_HEADS, RET_HEAD_DIM)
    qc, kc, vc = q.reshape(cshp), k.reshape(cshp), v.reshape(cshp)
    lg = log_gamma()
    idx = jnp.arange(chunk, dtype=f32)
    diff = idx[:, None] - idx[None, :]
    decay = jnp.where(diff >= 0, jnp.exp(lg[:, None, None] * jnp.maximum(diff, 0.0)), 0.0)
    zeta = jnp.exp(lg[:, None] * (chunk - 1 - idx))
    xi = jnp.exp(lg[:, None] * (idx + 1))
    g_chunk = jnp.exp(lg * chunk)[:, None, None]
    scores = jnp.einsum('bcihd,bcjhd->bchij', qc, kc) * decay
    o = jnp.einsum('bchij,bcjhe->bcihe', scores, vc)
    upd = jnp.einsum('bcjhd,hj,bcjhe->bchde', kc, zeta, vc)

    def step(s, u):
        return g_chunk * s + u, s

    s_final, s_prev = lax.scan(step, state0.astype(f32), jnp.moveaxis(upd, 1, 0))
    o = o + jnp.einsum('bcihd,cbhde,hi->bcihe', qc, s_prev, xi)
    o = o.reshape(b, l, RET_HEADS, RET_HEAD_DIM)
    o = o * lax.rsqrt(jnp.mean(o * o, axis=-1, keepdims=True) + EPS)
    o = o.reshape(b, l, RET_WIDTH) * gain.astype(f32)
    return (jax.nn.silu(g.astype(f32)) * o).astype(g.dtype), s_final.astype(state0.dtype)


def layer_forward(h, p_l, pos, attend, ret_state, ret_chunk, lw):
    (n_mix, w_in, sink, r_gain, w_out, n_mlp, w_up, w_down, n_ple, w_gate, w_ple) = lw
    b, l, _ = h.shape
    u = rmsnorm(h, n_mix)
    qa, ka, va, qr, kr, vr, gr = jnp.split(u @ w_in, SPLITS, axis=-1)
    qa = qa.reshape(b, l, ATT_KV_HEADS, ATT_GROUP, ATT_HEAD_DIM)
    ka = ka.reshape(b, l, ATT_KV_HEADS, ATT_HEAD_DIM)
    va = va.reshape(b, l, ATT_KV_HEADS, ATT_HEAD_DIM)
    oa, kv_rows = attend(qa, ka, va, sink)
    orr, ret_new = retention(qr, kr, vr, gr, r_gain, pos, ret_state, ret_chunk)
    h = h + jnp.concatenate([oa, orr.astype(oa.dtype)], axis=-1) @ w_out
    h = h + jnp.square(jax.nn.relu(rmsnorm(h, n_mlp) @ w_up)) @ w_down
    gate = jax.nn.sigmoid(rmsnorm(h, n_ple) @ w_gate)
    h = h + gate * (p_l.astype(h.dtype) @ w_ple)
    return h, kv_rows, ret_new


def setup_inputs(seed: int = 0) -> dict:
    key = jax.random.key(seed)
    ks = jax.random.split(key, 24)
    f32 = jnp.float32

    def nrm(k, shape, scale):
        return jax.random.normal(k, shape, f32) * scale

    def gain(k, shape):
        return 1.0 + 0.05 * jax.random.normal(k, shape, f32)

    return {
        "x_prompt": nrm(ks[0], (BATCH, SEQ, D_MODEL), 1.0),
        "x_sample": nrm(ks[1], (DEC_BATCH, DEC_SEQ, D_MODEL), 1.0),
        "cache_k": nrm(ks[2], (DEPTH, DEC_BATCH, WINDOW, ATT_KV_HEADS, ATT_HEAD_DIM), 1.0),
        "cache_v": nrm(ks[3], (DEPTH, DEC_BATCH, WINDOW, ATT_KV_HEADS, ATT_HEAD_DIM), 1.0),
        "state_ret": nrm(ks[4], (DEPTH, DEC_BATCH, RET_HEADS, RET_HEAD_DIM, RET_HEAD_DIM), 0.5),
        "p_prompt": nrm(ks[5], (DEPTH, BATCH, SEQ, PLE_DIM), 1.0),
        "p_sample": nrm(ks[6], (DEPTH, DEC_BATCH, DEC_SEQ, PLE_DIM), 1.0),
        "rel_bias": nrm(ks[7], (N_BUCKETS, ATT_HEADS), 0.5),
        "norm_mix": gain(ks[8], (DEPTH, D_MODEL)),
        "w_in": nrm(ks[9], (DEPTH, D_MODEL, IN_WIDTH), D_MODEL ** -0.5),
        "attn_sink": nrm(ks[10], (DEPTH, ATT_HEADS), 0.5),
        "ret_gain": gain(ks[11], (DEPTH, RET_WIDTH)),
        "w_out": nrm(ks[12], (DEPTH, MIX_WIDTH, D_MODEL), MIX_WIDTH ** -0.5),
        "norm_mlp": gain(ks[13], (DEPTH, D_MODEL)),
        "w_up": nrm(ks[14], (DEPTH, D_MODEL, D_FF), D_MODEL ** -0.5),
        "w_down": nrm(ks[15], (DEPTH, D_FF, D_MODEL), D_FF ** -0.5),
        "norm_ple": gain(ks[16], (DEPTH, D_MODEL)),
        "w_gate": nrm(ks[17], (DEPTH, D_MODEL, D_MODEL), D_MODEL ** -0.5),
        "w_ple": nrm(ks[18], (DEPTH, PLE_DIM, D_MODEL), PLE_DIM ** -0.5),
        "norm_final": gain(ks[19], (D_MODEL,)),
    }


def reference(x_prompt, x_sample, cache_k, cache_v, state_ret, p_prompt, p_sample,
              rel_bias, norm_mix, w_in, attn_sink, ret_gain, w_out, norm_mlp, w_up, w_down,
              norm_ple, w_gate, w_ple, norm_final):
    bsz, seq = x_prompt.shape[:2]
    dec_l = x_sample.shape[1]
    n_chunks = seq // CHUNK
    band_len = (WIN_CHUNKS + 1) * CHUNK
    q_idx = jnp.arange(CHUNK, dtype=jnp.int32)
    s_idx = jnp.arange(band_len, dtype=jnp.int32)
    bias_p = rel_bias_heads(rel_bias, s_idx[None, :] - WINDOW - q_idx[:, None])
    key_pos = jnp.arange(n_chunks, dtype=jnp.int32)[:, None] * CHUNK - WINDOW + s_idx[None, :]
    mask_p = (key_pos >= 0)[:, None, None, None, :]
    bias_s = rel_bias_heads(rel_bias, jnp.arange(WINDOW + dec_l, dtype=jnp.int32)[None, :] - WINDOW
                            - jnp.arange(dec_l, dtype=jnp.int32)[:, None])
    pos_p = jnp.arange(seq, dtype=jnp.int32)
    pos_s = PAST_LEN + jnp.arange(dec_l, dtype=jnp.int32)
    state0 = jnp.zeros((bsz, RET_HEADS, RET_HEAD_DIM, RET_HEAD_DIM), state_ret.dtype)

    hp, hs = x_prompt, x_sample
    kp_l, vp_l, sp_l, ks_l, vs_l, ss_l = [], [], [], [], [], []
    for l in range(DEPTH):
        lw = (norm_mix[l], w_in[l], attn_sink[l], ret_gain[l], w_out[l], norm_mlp[l],
              w_up[l], w_down[l], norm_ple[l], w_gate[l], w_ple[l])
        hp, (k_p, v_p), s_p = layer_forward(
            hp, p_prompt[l], pos_p,
            functools.partial(attend_prompt, bias=bias_p, mask=mask_p),
            state0, CHUNK, lw)
        hs, (k_s, v_s), s_s = layer_forward(
            hs, p_sample[l], pos_s,
            functools.partial(attend_sample, bias=bias_s, cache_k=cache_k[l], cache_v=cache_v[l]),
            state_ret[l], dec_l, lw)
        kp_l.append(k_p); vp_l.append(v_p); sp_l.append(s_p)
        ks_l.append(k_s); vs_l.append(v_s); ss_l.append(s_s)

    y_prompt = rmsnorm(hp, norm_final)
    y_sample = rmsnorm(hs, norm_final)
    new_k_prompt = jnp.stack(kp_l)
    new_v_prompt = jnp.stack(vp_l)
    new_state_prompt = jnp.stack(sp_l)
    new_k_sample = jnp.stack(ks_l)
    new_v_sample = jnp.stack(vs_l)
    new_state_sample = jnp.stack(ss_l)
    return (y_prompt, y_sample, new_k_prompt, new_v_prompt, new_state_prompt,
            new_k_sample, new_v_sample, new_state_sample)
```

```cpp
#include <hip/hip_runtime.h>
#include <cstdint>
#include <cstdio>

typedef float f32x4 __attribute__((ext_vector_type(4)));
typedef short bf16x8 __attribute__((ext_vector_type(8)));

constexpr int D = 2048, SEQ = 8192, NSAMP = 512, M = SEQ + NSAMP, INW = 5632, FFW = 8192, PLE = 256;
constexpr int DEC_B = 32, DEC_L = 16;
constexpr float EPS = 1e-6f;
constexpr size_t OFF_Y = 0;
constexpr size_t OFF_NKP = (size_t)M * D;
constexpr size_t OFF_NVP = OFF_NKP + 2 * 128 * 256;
constexpr size_t OFF_NSP = OFF_NVP + 2 * 128 * 256;
constexpr size_t OFF_NKS = OFF_NSP + 2 * 8 * 16384;
constexpr size_t OFF_NVS = OFF_NKS + 2 * 512 * 256;
constexpr size_t OFF_NSS = OFF_NVS + 2 * 512 * 256;
constexpr size_t MiB = 1u << 20;
constexpr size_t WS_H = 0, WS_U = 68 * MiB, WS_MIX = 136 * MiB, WS_BIG = 204 * MiB, WS_ORET = WS_BIG + 200 * MiB, WS_PB = 476 * MiB, WS_CS = 493 * MiB;

struct Params {
    const float *x_prompt, *x_sample, *cache_k, *cache_v, *state_ret, *p_prompt, *p_sample, *rel_bias, *norm_mix, *w_in, *attn_sink,
        *ret_gain, *w_out, *norm_mlp, *w_up, *w_down, *norm_ple, *w_gate, *w_ple, *norm_final;
    float* out; unsigned char* ws;
};

__device__ __forceinline__ unsigned f2bf(float f) { unsigned u = __float_as_uint(f); return (u + 0x7fffu + ((u >> 16) & 1u)) >> 16; }
__device__ __forceinline__ float wave_sum(float v) {
#pragma unroll
    for (int o = 1; o < 64; o <<= 1) v += __shfl_xor(v, o);
    return v;
}
__device__ __forceinline__ int t5_bucket(int rel) {
    const int ret = rel > 0 ? 16 : 0; const int n = rel < 0 ? -rel : rel;
    if (n < 8) return ret + n;
    const int v = (n * n) >> 6; int lg = 31 - __clz(v); int large = 8 + lg; if (large > 15) large = 15;
    return ret + large;
}

__device__ void ph_init(const Params& P) {
    float* H = (float*)(P.ws + WS_H); float* PB = (float*)(P.ws + WS_PB); float* CS = (float*)(P.ws + WS_CS);
    const size_t gt = (size_t)blockIdx.x * 512 + threadIdx.x, gs = (size_t)gridDim.x * 512;
    for (size_t i = gt; i < (size_t)M * D / 4; i += gs) {
        const size_t e = i * 4; f32x4 v;
        if (e < (size_t)SEQ * D) v = *(const f32x4*)(P.x_prompt + e); else v = *(const f32x4*)(P.x_sample + (e - (size_t)SEQ * D));
        *(f32x4*)(H + e) = v;
    }
    for (size_t i = gt; i < (size_t)2 * M * PLE / 4; i += gs) {
        const size_t e = i * 4; const int l = (int)(e / ((size_t)M * PLE)); const size_t r = e % ((size_t)M * PLE); f32x4 v;
        if (r < (size_t)SEQ * PLE) v = *(const f32x4*)(P.p_prompt + (size_t)l * SEQ * PLE + r); else v = *(const f32x4*)(P.p_sample + (size_t)l * NSAMP * PLE + (r - (size_t)SEQ * PLE));
        *(f32x4*)(PB + e) = v;
    }
    for (size_t i = gt; i < (size_t)SEQ * 64; i += gs) {
        const int pos = (int)(i >> 6), d = (int)(i & 63);
        const double inv = pow(10000.0, -(double)d / 64.0); const double ang = (double)pos * inv;
        CS[2 * i] = (float)cos(ang); CS[2 * i + 1] = (float)sin(ang);
    }
}

__device__ void ph_rmsnorm(const float* X, const float* g, float* Y) {
    const int lane = threadIdx.x & 63, gw = blockIdx.x * 8 + (threadIdx.x >> 6), ngw = gridDim.x * 8;
    for (int r = gw; r < M; r += ngw) {
        const f32x4* xr = (const f32x4*)(X + (size_t)r * D) + lane; f32x4 v[8]; float s = 0.f;
#pragma unroll
        for (int j = 0; j < 8; ++j) { v[j] = xr[64 * j]; s += v[j].x * v[j].x + v[j].y * v[j].y + v[j].z * v[j].z + v[j].w * v[j].w; }
        const float rs = rsqrtf(wave_sum(s) * (1.f / D) + EPS);
        f32x4* yr = (f32x4*)(Y + (size_t)r * D) + lane; const f32x4* gr = (const f32x4*)g + lane;
#pragma unroll
        for (int j = 0; j < 8; ++j) yr[64 * j] = v[j] * rs * gr[64 * j];
    }
}

struct EpiArgs { int mode; float* C; int ldc; const float* G; };
__device__ __forceinline__ void epi_apply(const EpiArgs& e, int row, int col, f32x4 v) {
    float* p = e.C + (size_t)row * e.ldc + col;
    if (e.mode == 0) *(f32x4*)p = v;
    else if (e.mode == 1) { const f32x4 o = *(f32x4*)p; *(f32x4*)p = o + v; }
    else if (e.mode == 2) { f32x4 r; for (int j = 0; j < 4; ++j) { const float t = v[j] > 0.f ? v[j] : 0.f; r[j] = t * t; } *(f32x4*)p = r; }
    else if (e.mode == 3) { f32x4 r; for (int j = 0; j < 4; ++j) r[j] = 1.f / (1.f + expf(-v[j])); *(f32x4*)p = r; }
    else { const f32x4 g = *(const f32x4*)(e.G + (size_t)row * e.ldc + col); const f32x4 o = *(f32x4*)p; *(f32x4*)p = o + g * v; }
}
__device__ void gemm_naive(const float* A, int lda, const float* W, int N, int K, EpiArgs e, unsigned char* lds) {
    unsigned short* sA = (unsigned short*)lds; unsigned short* sB = sA + 128 * 40;
    const int tid = threadIdx.x, lane = tid & 63, wid = tid >> 6, wm = wid >> 1, wn = wid & 1, fr = lane & 15, fq = lane >> 4;
    const int nM = M / 128, nN = N / 128;
    for (int t = blockIdx.x; t < nM * nN; t += gridDim.x) {
        const int m0 = (t / nN) * 128, n0 = (t % nN) * 128;
        f32x4 acc[2][4];
#pragma unroll
        for (int a = 0; a < 2; ++a)
#pragma unroll
            for (int b = 0; b < 4; ++b) acc[a][b] = (f32x4){0.f, 0.f, 0.f, 0.f};
        for (int k0 = 0; k0 < K; k0 += 32) {
#pragma unroll
            for (int i = 0; i < 2; ++i) { const int idx = tid + i * 512, r = idx >> 3, c4 = idx & 7;
                const f32x4 v = *(const f32x4*)(A + (size_t)(m0 + r) * lda + k0 + c4 * 4);
                uint2 w; w.x = f2bf(v.x) | (f2bf(v.y) << 16); w.y = f2bf(v.z) | (f2bf(v.w) << 16);
                *(uint2*)(sA + r * 40 + c4 * 4) = w; }
#pragma unroll
            for (int i = 0; i < 2; ++i) { const int idx = tid + i * 512, kk = idx >> 5, n4 = idx & 31;
                const f32x4 v = *(const f32x4*)(W + (size_t)(k0 + kk) * N + n0 + n4 * 4);
                sB[(n4 * 4 + 0) * 40 + kk] = (unsigned short)f2bf(v.x); sB[(n4 * 4 + 1) * 40 + kk] = (unsigned short)f2bf(v.y);
                sB[(n4 * 4 + 2) * 40 + kk] = (unsigned short)f2bf(v.z); sB[(n4 * 4 + 3) * 40 + kk] = (unsigned short)f2bf(v.w); }
            __syncthreads();
            bf16x8 xa[2], wb[4];
#pragma unroll
            for (int mi = 0; mi < 2; ++mi) xa[mi] = *(const bf16x8*)(sA + (wm * 32 + mi * 16 + fr) * 40 + fq * 8);
#pragma unroll
            for (int ni = 0; ni < 4; ++ni) wb[ni] = *(const bf16x8*)(sB + (wn * 64 + ni * 16 + fr) * 40 + fq * 8);
#pragma unroll
            for (int mi = 0; mi < 2; ++mi)
#pragma unroll
                for (int ni = 0; ni < 4; ++ni) acc[mi][ni] = __builtin_amdgcn_mfma_f32_16x16x32_bf16(wb[ni], xa[mi], acc[mi][ni], 0, 0, 0);
            __syncthreads();
        }
#pragma unroll
        for (int mi = 0; mi < 2; ++mi)
#pragma unroll
            for (int ni = 0; ni < 4; ++ni) epi_apply(e, m0 + wm * 32 + mi * 16 + fr, n0 + wn * 64 + ni * 16 + fq * 4, acc[mi][ni]);
    }
}

__device__ void ph_post_proj(const Params& P, int l) {
    float* PROJ = (float*)(P.ws + WS_BIG); const float* CS = (const float*)(P.ws + WS_CS);
    const size_t gt = (size_t)blockIdx.x * 512 + threadIdx.x, gs = (size_t)gridDim.x * 512;
    const float RS = 0.08838834764831845f;
    for (size_t i = gt; i < (size_t)M * 2 * 8 * 64; i += gs) {
        const int d = (int)(i & 63), h = (int)((i >> 6) & 7), which = (int)((i >> 9) & 1), row = (int)(i >> 10);
        const int pos = row < SEQ ? row : 4096 + ((row - SEQ) & 15);
        const float c = CS[(size_t)(pos * 64 + d) * 2], s = CS[(size_t)(pos * 64 + d) * 2 + 1];
        float* p = PROJ + (size_t)row * INW + (which ? 2560 : 1536) + h * 128 + d;
        const float x1 = p[0], x2 = p[64]; float o1 = x1 * c - x2 * s, o2 = x2 * c + x1 * s;
        if (which) { o1 *= RS; o2 *= RS; }
        p[0] = o1; p[64] = o2;
    }
    for (size_t i = gt; i < (size_t)(128 + 512) * 512; i += gs) {
        const int c = (int)(i & 511), rr = (int)(i >> 9); const int row = 8064 + rr; const int kv = c >> 8, cc = c & 255;
        const float v = PROJ[(size_t)row * INW + 1024 + kv * 256 + cc];
        if (rr < 128) P.out[(kv ? OFF_NVP : OFF_NKP) + (size_t)l * 128 * 256 + (size_t)rr * 256 + cc] = v;
        else P.out[(kv ? OFF_NVS : OFF_NKS) + (size_t)l * 512 * 256 + (size_t)(rr - 128) * 256 + cc] = v;
    }
}

__device__ void ph_attn_naive(const Params& P, int l) {
    const float* PROJ = (const float*)(P.ws + WS_BIG); float* MIX = (float*)(P.ws + WS_MIX);
    const int nP = SEQ * 16, nS = NSAMP * 16;
    for (int it = blockIdx.x * 512 + threadIdx.x; it < nP + nS; it += gridDim.x * 512) {
        const bool sample = it >= nP; int row, hq, c = 0, b = 0, qi = 0;
        if (!sample) { const int q = it & 63; hq = (it >> 6) & 15; c = it >> 10; row = c * 64 + q; }
        else { const int j = it - nP; qi = j & 15; hq = (j >> 4) & 15; b = j >> 8; row = SEQ + b * 16 + qi; }
        const int kh = hq >> 2; const float sink = P.attn_sink[l * 16 + hq];
        float q[64], acc[64];
#pragma unroll
        for (int d4 = 0; d4 < 16; ++d4) { const f32x4 v = *(const f32x4*)(PROJ + (size_t)row * INW + hq * 64 + d4 * 4); q[d4 * 4] = v.x; q[d4 * 4 + 1] = v.y; q[d4 * 4 + 2] = v.z; q[d4 * 4 + 3] = v.w; }
#pragma unroll
        for (int d = 0; d < 64; ++d) acc[d] = 0.f;
        float m = sink, ls = 1.f;
        const int nk = sample ? 144 : 192;
        for (int s = 0; s < nk; ++s) {
            const float *kp, *vp; int rel;
            if (!sample) { const int kpos = c * 64 - 128 + s; if (kpos < 0) continue; rel = kpos - row; kp = PROJ + (size_t)kpos * INW + 1024 + kh * 64; vp = kp + 256; }
            else { rel = s - 128 - qi;
                if (s < 128) { const size_t o = ((((size_t)l * DEC_B + b) * 128 + s) * 4 + kh) * 64; kp = P.cache_k + o; vp = P.cache_v + o; }
                else { kp = PROJ + (size_t)(SEQ + b * 16 + (s - 128)) * INW + 1024 + kh * 64; vp = kp + 256; } }
            float dot = 0.f;
#pragma unroll
            for (int d4 = 0; d4 < 16; ++d4) { const f32x4 v = *(const f32x4*)(kp + d4 * 4); dot += q[d4 * 4] * v.x + q[d4 * 4 + 1] * v.y + q[d4 * 4 + 2] * v.z + q[d4 * 4 + 3] * v.w; }
            const float sc = dot * 0.125f + P.rel_bias[t5_bucket(rel) * 16 + hq];
            const float mn = fmaxf(m, sc), corr = expf(m - mn), p = expf(sc - mn);
            ls = ls * corr + p; m = mn;
#pragma unroll
            for (int d4 = 0; d4 < 16; ++d4) { const f32x4 v = *(const f32x4*)(vp + d4 * 4);
                acc[d4 * 4] = acc[d4 * 4] * corr + p * v.x; acc[d4 * 4 + 1] = acc[d4 * 4 + 1] * corr + p * v.y; acc[d4 * 4 + 2] = acc[d4 * 4 + 2] * corr + p * v.z; acc[d4 * 4 + 3] = acc[d4 * 4 + 3] * corr + p * v.w; }
        }
        const float inv = 1.f / ls;
#pragma unroll
        for (int d4 = 0; d4 < 16; ++d4) *(f32x4*)(MIX + (size_t)row * D + hq * 64 + d4 * 4) = (f32x4){acc[d4 * 4] * inv, acc[d4 * 4 + 1] * inv, acc[d4 * 4 + 2] * inv, acc[d4 * 4 + 3] * inv};
    }
}

__device__ void ph_ret_naive(const Params& P, int l, unsigned char* lds) {
    const float* PROJ = (const float*)(P.ws + WS_BIG); float* ORET = (float*)(P.ws + WS_ORET);
    float* sq = (float*)lds; float* sk = sq + 16 * 128;
    const int tid = threadIdx.x;
    for (int it = blockIdx.x; it < 33 * 8; it += gridDim.x) {
        const int seq = it >> 3, h = it & 7; const int len = seq == 0 ? SEQ : 16; const int row0 = seq == 0 ? 0 : SEQ + (seq - 1) * 16;
        const float gamma = 1.f - exp2f(-5.f - (float)h);
        float S[128]; const int e = tid & 127;
        if (seq == 0) {
#pragma unroll
            for (int d = 0; d < 128; ++d) S[d] = 0.f;
        } else {
            const float* s0 = P.state_ret + (((size_t)l * DEC_B + (seq - 1)) * 8 + h) * 16384;
#pragma unroll
            for (int d = 0; d < 128; ++d) S[d] = s0[d * 128 + e];
        }
        for (int t0 = 0; t0 < len; t0 += 16) {
            __syncthreads();
            for (int i = tid; i < 4096; i += 512) { const int tt = i >> 8, dd = i & 255, which = dd >> 7, d = dd & 127;
                const float v = PROJ[(size_t)(row0 + t0 + tt) * INW + (which ? 2560 : 1536) + h * 128 + d]; (which ? sk : sq)[tt * 128 + d] = v; }
            __syncthreads();
            if (tid < 128) {
                for (int tt = 0; tt < 16; ++tt) {
                    const float v = PROJ[(size_t)(row0 + t0 + tt) * INW + 3584 + h * 128 + e]; float o = 0.f;
#pragma unroll
                    for (int d = 0; d < 128; ++d) { S[d] = gamma * S[d] + sk[tt * 128 + d] * v; o += sq[tt * 128 + d] * S[d]; }
                    ORET[(size_t)(row0 + t0 + tt) * 1024 + h * 128 + e] = o;
                }
            }
        }
        if (tid < 128) {
            float* so = P.out + (seq == 0 ? OFF_NSP + ((size_t)l * 8 + h) * 16384 : OFF_NSS + (((size_t)l * DEC_B + (seq - 1)) * 8 + h) * 16384);
#pragma unroll
            for (int d = 0; d < 128; ++d) so[d * 128 + e] = S[d];
        }
    }
}
__device__ void ph_ret_finish(const Params& P, int l) {
    const float* PROJ = (const float*)(P.ws + WS_BIG); const float* ORET = (const float*)(P.ws + WS_ORET); float* MIX = (float*)(P.ws + WS_MIX);
    const int lane = threadIdx.x & 63, gw = blockIdx.x * 8 + (threadIdx.x >> 6), ngw = gridDim.x * 8;
    for (int it = gw; it < M * 8; it += ngw) {
        const int row = it >> 3, h = it & 7;
        const float o0 = ORET[(size_t)row * 1024 + h * 128 + lane], o1 = ORET[(size_t)row * 1024 + h * 128 + 64 + lane];
        const float rs = rsqrtf(wave_sum(o0 * o0 + o1 * o1) * (1.f / 128.f) + EPS);
        const float g0 = PROJ[(size_t)row * INW + 4608 + h * 128 + lane], g1 = PROJ[(size_t)row * INW + 4608 + h * 128 + 64 + lane];
        const float gn0 = P.ret_gain[l * 1024 + h * 128 + lane], gn1 = P.ret_gain[l * 1024 + h * 128 + 64 + lane];
        MIX[(size_t)row * D + 1024 + h * 128 + lane] = (g0 / (1.f + expf(-g0))) * (o0 * rs * gn0);
        MIX[(size_t)row * D + 1024 + h * 128 + 64 + lane] = (g1 / (1.f + expf(-g1))) * (o1 * rs * gn1);
    }
}

__global__ void __launch_bounds__(512) k_phase(Params P, int phase, int l) {
    __shared__ __attribute__((aligned(16))) unsigned char lds[32768];
    float* H = (float*)(P.ws + WS_H); float* U = (float*)(P.ws + WS_U); float* MIX = (float*)(P.ws + WS_MIX); float* BIG = (float*)(P.ws + WS_BIG);
    float* PB = (float*)(P.ws + WS_PB);
    switch (phase) {
    case 0: ph_init(P); break;
    case 1: ph_rmsnorm(H, P.norm_mix + l * D, U); break;
    case 2: gemm_naive(U, D, P.w_in + (size_t)l * D * INW, INW, D, EpiArgs{0, BIG, INW, nullptr}, lds); break;
    case 3: ph_post_proj(P, l); break;
    case 4: ph_attn_naive(P, l); break;
    case 5: ph_ret_naive(P, l, lds); break;
    case 6: ph_ret_finish(P, l); break;
    case 7: gemm_naive(MIX, D, P.w_out + (size_t)l * D * D, D, D, EpiArgs{1, H, D, nullptr}, lds); break;
    case 8: ph_rmsnorm(H, P.norm_mlp + l * D, U); break;
    case 9: gemm_naive(U, D, P.w_up + (size_t)l * D * FFW, FFW, D, EpiArgs{2, BIG, FFW, nullptr}, lds); break;
    case 10: gemm_naive(BIG, FFW, P.w_down + (size_t)l * FFW * D, D, FFW, EpiArgs{1, H, D, nullptr}, lds); break;
    case 11: ph_rmsnorm(H, P.norm_ple + l * D, U); break;
    case 12: gemm_naive(U, D, P.w_gate + (size_t)l * D * D, D, D, EpiArgs{3, MIX, D, nullptr}, lds); break;
    case 13: gemm_naive(PB + (size_t)l * M * PLE, PLE, P.w_ple + (size_t)l * PLE * D, D, PLE, EpiArgs{4, H, D, MIX}, lds); break;
    case 14: ph_rmsnorm(H, P.norm_final, P.out + OFF_Y); break;
    }
}

extern "C" void kernel_launch(void* const* d_in, const int* in_sizes, int n_in, void* d_out, int out_size, void* d_ws, size_t ws_size, hipStream_t stream) {
    Params P{};
    const float** pp = (const float**)&P;
    for (int i = 0; i < 20; ++i) pp[i] = (const float*)d_in[i];
    P.out = (float*)d_out; P.ws = (unsigned char*)d_ws;
    const int G = 1024;
    hipLaunchKernelGGL(k_phase, dim3(G), dim3(512), 0, stream, P, 0, 0);
    for (int l = 0; l < 2; ++l)
        for (int ph = 1; ph <= 13; ++ph) hipLaunchKernelGGL(k_phase, dim3(G), dim3(512), 0, stream, P, ph, l);
    hipLaunchKernelGGL(k_phase, dim3(G), dim3(512), 0, stream, P, 14, 0);
}
```

```cpp
#include <hip/hip_runtime.h>
#include <hip/hip_cooperative_groups.h>
namespace cg = cooperative_groups;
#include <cstdint>
#include <cstdio>

typedef float f32x4 __attribute__((ext_vector_type(4)));
typedef short bf16x8 __attribute__((ext_vector_type(8)));

constexpr int D = 2048, SEQ = 8192, NSAMP = 512, M = SEQ + NSAMP, INW = 5632, FFW = 8192, PLE = 256;
constexpr int DEC_B = 32, DEC_L = 16;
constexpr float EPS = 1e-6f;
constexpr size_t OFF_Y = 0;
constexpr size_t OFF_NKP = (size_t)M * D;
constexpr size_t OFF_NVP = OFF_NKP + 2 * 128 * 256;
constexpr size_t OFF_NSP = OFF_NVP + 2 * 128 * 256;
constexpr size_t OFF_NKS = OFF_NSP + 2 * 8 * 16384;
constexpr size_t OFF_NVS = OFF_NKS + 2 * 512 * 256;
constexpr size_t OFF_NSS = OFF_NVS + 2 * 512 * 256;
constexpr size_t MiB = 1u << 20;
constexpr size_t WS_H = 0, WS_U = 68 * MiB, WS_MIX = 136 * MiB, WS_BIG = 204 * MiB, WS_ORET = WS_BIG + 200 * MiB, WS_PB = 476 * MiB, WS_CS = 493 * MiB;

struct Params {
    const float *x_prompt, *x_sample, *cache_k, *cache_v, *state_ret, *p_prompt, *p_sample, *rel_bias, *norm_mix, *w_in, *attn_sink,
        *ret_gain, *w_out, *norm_mlp, *w_up, *w_down, *norm_ple, *w_gate, *w_ple, *norm_final;
    float* out; unsigned char* ws;
};

__device__ __forceinline__ unsigned f2bf(float f) { unsigned u = __float_as_uint(f); return (u + 0x7fffu + ((u >> 16) & 1u)) >> 16; }
__device__ __forceinline__ float wave_sum(float v) {
#pragma unroll
    for (int o = 1; o < 64; o <<= 1) v += __shfl_xor(v, o);
    return v;
}
__device__ __forceinline__ int t5_bucket(int rel) {
    const int ret = rel > 0 ? 16 : 0; const int n = rel < 0 ? -rel : rel;
    if (n < 8) return ret + n;
    const int v = (n * n) >> 6; int lg = 31 - __clz(v); int large = 8 + lg; if (large > 15) large = 15;
    return ret + large;
}

__device__ void ph_init(const Params& P) {
    float* H = (float*)(P.ws + WS_H); float* PB = (float*)(P.ws + WS_PB); float* CS = (float*)(P.ws + WS_CS);
    const size_t gt = (size_t)blockIdx.x * 512 + threadIdx.x, gs = (size_t)gridDim.x * 512;
    for (size_t i = gt; i < (size_t)M * D / 4; i += gs) {
        const size_t e = i * 4; f32x4 v;
        if (e < (size_t)SEQ * D) v = *(const f32x4*)(P.x_prompt + e); else v = *(const f32x4*)(P.x_sample + (e - (size_t)SEQ * D));
        *(f32x4*)(H + e) = v;
    }
    for (size_t i = gt; i < (size_t)2 * M * PLE / 4; i += gs) {
        const size_t e = i * 4; const int l = (int)(e / ((size_t)M * PLE)); const size_t r = e % ((size_t)M * PLE); f32x4 v;
        if (r < (size_t)SEQ * PLE) v = *(const f32x4*)(P.p_prompt + (size_t)l * SEQ * PLE + r); else v = *(const f32x4*)(P.p_sample + (size_t)l * NSAMP * PLE + (r - (size_t)SEQ * PLE));
        *(f32x4*)(PB + e) = v;
    }
    for (size_t i = gt; i < (size_t)SEQ * 64; i += gs) {
        const int pos = (int)(i >> 6), d = (int)(i & 63);
        const double inv = pow(10000.0, -(double)d / 64.0); const double ang = (double)pos * inv;
        CS[2 * i] = (float)cos(ang); CS[2 * i + 1] = (float)sin(ang);
    }
}

__device__ void ph_rmsnorm(const float* X, const float* g, float* Y) {
    const int lane = threadIdx.x & 63, gw = blockIdx.x * 8 + (threadIdx.x >> 6), ngw = gridDim.x * 8;
    for (int r = gw; r < M; r += ngw) {
        const f32x4* xr = (const f32x4*)(X + (size_t)r * D) + lane; f32x4 v[8]; float s = 0.f;
#pragma unroll
        for (int j = 0; j < 8; ++j) { v[j] = xr[64 * j]; s += v[j].x * v[j].x + v[j].y * v[j].y + v[j].z * v[j].z + v[j].w * v[j].w; }
        const float rs = rsqrtf(wave_sum(s) * (1.f / D) + EPS);
        f32x4* yr = (f32x4*)(Y + (size_t)r * D) + lane; const f32x4* gr = (const f32x4*)g + lane;
#pragma unroll
        for (int j = 0; j < 8; ++j) yr[64 * j] = v[j] * rs * gr[64 * j];
    }
}

struct EpiArgs { int mode; float* C; int ldc; const float* G; };
__device__ __forceinline__ void epi_apply(const EpiArgs& e, int row, int col, f32x4 v) {
    float* p = e.C + (size_t)row * e.ldc + col;
    if (e.mode == 0) *(f32x4*)p = v;
    else if (e.mode == 1) { const f32x4 o = *(f32x4*)p; *(f32x4*)p = o + v; }
    else if (e.mode == 2) { f32x4 r; for (int j = 0; j < 4; ++j) { const float t = v[j] > 0.f ? v[j] : 0.f; r[j] = t * t; } *(f32x4*)p = r; }
    else if (e.mode == 3) { f32x4 r; for (int j = 0; j < 4; ++j) r[j] = 1.f / (1.f + expf(-v[j])); *(f32x4*)p = r; }
    else { const f32x4 g = *(const f32x4*)(e.G + (size_t)row * e.ldc + col); const f32x4 o = *(f32x4*)p; *(f32x4*)p = o + g * v; }
}
__device__ void gemm_naive(const float* A, int lda, const float* W, int N, int K, EpiArgs e, unsigned char* lds) {
    unsigned short* sA = (unsigned short*)lds; unsigned short* sB = sA + 128 * 40;
    const int tid = threadIdx.x, lane = tid & 63, wid = tid >> 6, wm = wid >> 1, wn = wid & 1, fr = lane & 15, fq = lane >> 4;
    const int nM = M / 128, nN = N / 128;
    for (int t = blockIdx.x; t < nM * nN; t += gridDim.x) {
        const int m0 = (t / nN) * 128, n0 = (t % nN) * 128;
        f32x4 acc[2][4];
#pragma unroll
        for (int a = 0; a < 2; ++a)
#pragma unroll
            for (int b = 0; b < 4; ++b) acc[a][b] = (f32x4){0.f, 0.f, 0.f, 0.f};
        for (int k0 = 0; k0 < K; k0 += 32) {
#pragma unroll
            for (int i = 0; i < 2; ++i) { const int idx = tid + i * 512, r = idx >> 3, c4 = idx & 7;
                const f32x4 v = *(const f32x4*)(A + (size_t)(m0 + r) * lda + k0 + c4 * 4);
                uint2 w; w.x = f2bf(v.x) | (f2bf(v.y) << 16); w.y = f2bf(v.z) | (f2bf(v.w) << 16);
                *(uint2*)(sA + r * 40 + c4 * 4) = w; }
#pragma unroll
            for (int i = 0; i < 2; ++i) { const int idx = tid + i * 512, kk = idx >> 5, n4 = idx & 31;
                const f32x4 v = *(const f32x4*)(W + (size_t)(k0 + kk) * N + n0 + n4 * 4);
                sB[(n4 * 4 + 0) * 40 + kk] = (unsigned short)f2bf(v.x); sB[(n4 * 4 + 1) * 40 + kk] = (unsigned short)f2bf(v.y);
                sB[(n4 * 4 + 2) * 40 + kk] = (unsigned short)f2bf(v.z); sB[(n4 * 4 + 3) * 40 + kk] = (unsigned short)f2bf(v.w); }
            __syncthreads();
            bf16x8 xa[2], wb[4];
#pragma unroll
            for (int mi = 0; mi < 2; ++mi) xa[mi] = *(const bf16x8*)(sA + (wm * 32 + mi * 16 + fr) * 40 + fq * 8);
#pragma unroll
            for (int ni = 0; ni < 4; ++ni) wb[ni] = *(const bf16x8*)(sB + (wn * 64 + ni * 16 + fr) * 40 + fq * 8);
#pragma unroll
            for (int mi = 0; mi < 2; ++mi)
#pragma unroll
                for (int ni = 0; ni < 4; ++ni) acc[mi][ni] = __builtin_amdgcn_mfma_f32_16x16x32_bf16(wb[ni], xa[mi], acc[mi][ni], 0, 0, 0);
            __syncthreads();
        }
#pragma unroll
        for (int mi = 0; mi < 2; ++mi)
#pragma unroll
            for (int ni = 0; ni < 4; ++ni) epi_apply(e, m0 + wm * 32 + mi * 16 + fr, n0 + wn * 64 + ni * 16 + fq * 4, acc[mi][ni]);
    }
}

__device__ void ph_post_proj(const Params& P, int l) {
    float* PROJ = (float*)(P.ws + WS_BIG); const float* CS = (const float*)(P.ws + WS_CS);
    const size_t gt = (size_t)blockIdx.x * 512 + threadIdx.x, gs = (size_t)gridDim.x * 512;
    const float RS = 0.08838834764831845f;
    for (size_t i = gt; i < (size_t)M * 2 * 8 * 64; i += gs) {
        const int d = (int)(i & 63), h = (int)((i >> 6) & 7), which = (int)((i >> 9) & 1), row = (int)(i >> 10);
        const int pos = row < SEQ ? row : 4096 + ((row - SEQ) & 15);
        const float c = CS[(size_t)(pos * 64 + d) * 2], s = CS[(size_t)(pos * 64 + d) * 2 + 1];
        float* p = PROJ + (size_t)row * INW + (which ? 2560 : 1536) + h * 128 + d;
        const float x1 = p[0], x2 = p[64]; float o1 = x1 * c - x2 * s, o2 = x2 * c + x1 * s;
        if (which) { o1 *= RS; o2 *= RS; }
        p[0] = o1; p[64] = o2;
    }
    for (size_t i = gt; i < (size_t)(128 + 512) * 512; i += gs) {
        const int c = (int)(i & 511), rr = (int)(i >> 9); const int row = 8064 + rr; const int kv = c >> 8, cc = c & 255;
        const float v = PROJ[(size_t)row * INW + 1024 + kv * 256 + cc];
        if (rr < 128) P.out[(kv ? OFF_NVP : OFF_NKP) + (size_t)l * 128 * 256 + (size_t)rr * 256 + cc] = v;
        else P.out[(kv ? OFF_NVS : OFF_NKS) + (size_t)l * 512 * 256 + (size_t)(rr - 128) * 256 + cc] = v;
    }
}

__device__ void ph_attn_naive(const Params& P, int l) {
    const float* PROJ = (const float*)(P.ws + WS_BIG); float* MIX = (float*)(P.ws + WS_MIX);
    const int nP = SEQ * 16 * 4, nS = NSAMP * 16 * 4;
    for (int it = blockIdx.x * 512 + threadIdx.x; it < nP + nS; it += gridDim.x * 512) {
        const bool sample = it >= nP; int row, hq, c = 0, b = 0, qi = 0; const int part = it & 3;
        if (!sample) { const int q = (it >> 2) & 63; hq = (it >> 8) & 15; c = it >> 12; row = c * 64 + q; }
        else { const int j = it - nP; qi = (j >> 2) & 15; hq = (j >> 6) & 15; b = j >> 10; row = SEQ + b * 16 + qi; }
        const int kh = hq >> 2; const float sink = P.attn_sink[l * 16 + hq];
        f32x4 q[4], acc[4];
#pragma unroll
        for (int d4 = 0; d4 < 4; ++d4) { q[d4] = *(const f32x4*)(PROJ + (size_t)row * INW + hq * 64 + part * 16 + d4 * 4); acc[d4] = (f32x4){0.f, 0.f, 0.f, 0.f}; }
        float m = sink, ls = 1.f;
        const int nk = sample ? 144 : 192;
#pragma unroll 1
        for (int s = 0; s < nk; ++s) {
            const float *kp, *vp; int rel;
            if (!sample) { const int kpos = c * 64 - 128 + s; if (kpos < 0) continue; rel = kpos - row; kp = PROJ + (size_t)kpos * INW + 1024 + kh * 64; vp = kp + 256; }
            else { rel = s - 128 - qi;
                if (s < 128) { const size_t o = ((((size_t)l * DEC_B + b) * 128 + s) * 4 + kh) * 64; kp = P.cache_k + o; vp = P.cache_v + o; }
                else { kp = PROJ + (size_t)(SEQ + b * 16 + (s - 128)) * INW + 1024 + kh * 64; vp = kp + 256; } }
            float dot = 0.f;
#pragma unroll
            for (int d4 = 0; d4 < 4; ++d4) { const f32x4 v = *(const f32x4*)(kp + part * 16 + d4 * 4); dot += q[d4].x * v.x + q[d4].y * v.y + q[d4].z * v.z + q[d4].w * v.w; }
            dot += __shfl_xor(dot, 1); dot += __shfl_xor(dot, 2);
            const float sc = dot * 0.125f + P.rel_bias[t5_bucket(rel) * 16 + hq];
            const float mn = fmaxf(m, sc), corr = expf(m - mn), p = expf(sc - mn);
            ls = ls * corr + p; m = mn;
#pragma unroll
            for (int d4 = 0; d4 < 4; ++d4) { const f32x4 v = *(const f32x4*)(vp + part * 16 + d4 * 4); acc[d4] = acc[d4] * corr + v * p; }
        }
        const float inv = 1.f / ls;
#pragma unroll
        for (int d4 = 0; d4 < 4; ++d4) *(f32x4*)(MIX + (size_t)row * D + hq * 64 + part * 16 + d4 * 4) = acc[d4] * inv;
    }
}

__device__ void ph_ret_naive(const Params& P, int l, unsigned char* lds) {
    const float* PROJ = (const float*)(P.ws + WS_BIG); float* ORET = (float*)(P.ws + WS_ORET);
    float* sq = (float*)lds; float* sk = sq + 16 * 128; float* so = sk + 16 * 128;
    const int tid = threadIdx.x;
    for (int it = blockIdx.x; it < 33 * 8; it += gridDim.x) {
        const int seq = it >> 3, h = it & 7; const int len = seq == 0 ? SEQ : 16; const int row0 = seq == 0 ? 0 : SEQ + (seq - 1) * 16;
        const float gamma = 1.f - exp2f(-5.f - (float)h);
        float S[64]; const int e = tid & 127, half = (tid >> 7) & 1;
        if (seq == 0) {
#pragma unroll
            for (int d = 0; d < 64; ++d) S[d] = 0.f;
        } else {
            const float* s0 = P.state_ret + (((size_t)l * DEC_B + (seq - 1)) * 8 + h) * 16384;
#pragma unroll
            for (int d = 0; d < 64; ++d) S[d] = s0[(half * 64 + d) * 128 + e];
        }
        for (int t0 = 0; t0 < len; t0 += 16) {
            __syncthreads();
            for (int i = tid; i < 4096; i += 512) { const int tt = i >> 8, dd = i & 255, which = dd >> 7, d = dd & 127;
                const float v = PROJ[(size_t)(row0 + t0 + tt) * INW + (which ? 2560 : 1536) + h * 128 + d]; (which ? sk : sq)[tt * 128 + d] = v; }
            __syncthreads();
            if (tid < 256) {
#pragma unroll 1
                for (int tt = 0; tt < 16; ++tt) {
                    const float v = PROJ[(size_t)(row0 + t0 + tt) * INW + 3584 + h * 128 + e]; float o = 0.f;
#pragma unroll
                    for (int d = 0; d < 64; ++d) { S[d] = gamma * S[d] + sk[tt * 128 + half * 64 + d] * v; o += sq[tt * 128 + half * 64 + d] * S[d]; }
                    so[(tt * 2 + half) * 128 + e] = o;
                }
            }
            __syncthreads();
            for (int i = tid; i < 2048; i += 512) { const int tt = i >> 7, ee = i & 127;
                ORET[(size_t)(row0 + t0 + tt) * 1024 + h * 128 + ee] = so[(tt * 2) * 128 + ee] + so[(tt * 2 + 1) * 128 + ee]; }
        }
        if (tid < 256) {
            float* sp = P.out + (seq == 0 ? OFF_NSP + ((size_t)l * 8 + h) * 16384 : OFF_NSS + (((size_t)l * DEC_B + (seq - 1)) * 8 + h) * 16384);
#pragma unroll
            for (int d = 0; d < 64; ++d) sp[(half * 64 + d) * 128 + e] = S[d];
        }
    }
}
__device__ void ph_ret_finish(const Params& P, int l) {
    const float* PROJ = (const float*)(P.ws + WS_BIG); const float* ORET = (const float*)(P.ws + WS_ORET); float* MIX = (float*)(P.ws + WS_MIX);
    const int lane = threadIdx.x & 63, gw = blockIdx.x * 8 + (threadIdx.x >> 6), ngw = gridDim.x * 8;
    for (int it = gw; it < M * 8; it += ngw) {
        const int row = it >> 3, h = it & 7;
        const float o0 = ORET[(size_t)row * 1024 + h * 128 + lane], o1 = ORET[(size_t)row * 1024 + h * 128 + 64 + lane];
        const float rs = rsqrtf(wave_sum(o0 * o0 + o1 * o1) * (1.f / 128.f) + EPS);
        const float g0 = PROJ[(size_t)row * INW + 4608 + h * 128 + lane], g1 = PROJ[(size_t)row * INW + 4608 + h * 128 + 64 + lane];
        const float gn0 = P.ret_gain[l * 1024 + h * 128 + lane], gn1 = P.ret_gain[l * 1024 + h * 128 + 64 + lane];
        MIX[(size_t)row * D + 1024 + h * 128 + lane] = (g0 / (1.f + expf(-g0))) * (o0 * rs * gn0);
        MIX[(size_t)row * D + 1024 + h * 128 + 64 + lane] = (g1 / (1.f + expf(-g1))) * (o1 * rs * gn1);
    }
}

__global__ void __launch_bounds__(512) k_mega(Params P) {
    __shared__ __attribute__((aligned(16))) unsigned char lds[32768];
    cg::grid_group grid = cg::this_grid();
    float* H = (float*)(P.ws + WS_H); float* U = (float*)(P.ws + WS_U); float* MIX = (float*)(P.ws + WS_MIX); float* BIG = (float*)(P.ws + WS_BIG);
    float* PB = (float*)(P.ws + WS_PB);
    ph_init(P); grid.sync();
    for (int l = 0; l < 2; ++l) {
        ph_rmsnorm(H, P.norm_mix + l * D, U); grid.sync();
        gemm_naive(U, D, P.w_in + (size_t)l * D * INW, INW, D, EpiArgs{0, BIG, INW, nullptr}, lds); grid.sync();
        ph_post_proj(P, l); grid.sync();
        ph_attn_naive(P, l);
        ph_ret_naive(P, l, lds); grid.sync();
        ph_ret_finish(P, l); grid.sync();
        gemm_naive(MIX, D, P.w_out + (size_t)l * D * D, D, D, EpiArgs{1, H, D, nullptr}, lds); grid.sync();
        ph_rmsnorm(H, P.norm_mlp + l * D, U); grid.sync();
        gemm_naive(U, D, P.w_up + (size_t)l * D * FFW, FFW, D, EpiArgs{2, BIG, FFW, nullptr}, lds); grid.sync();
        gemm_naive(BIG, FFW, P.w_down + (size_t)l * FFW * D, D, FFW, EpiArgs{1, H, D, nullptr}, lds); grid.sync();
        ph_rmsnorm(H, P.norm_ple + l * D, U); grid.sync();
        gemm_naive(U, D, P.w_gate + (size_t)l * D * D, D, D, EpiArgs{3, MIX, D, nullptr}, lds); grid.sync();
        gemm_naive(PB + (size_t)l * M * PLE, PLE, P.w_ple + (size_t)l * PLE * D, D, PLE, EpiArgs{4, H, D, MIX}, lds); grid.sync();
    }
    ph_rmsnorm(H, P.norm_final, P.out + OFF_Y);
}

extern "C" void kernel_launch(void* const* d_in, const int* in_sizes, int n_in, void* d_out, int out_size, void* d_ws, size_t ws_size, hipStream_t stream) {
    static int grid_blocks = 0;
    if (!grid_blocks) {
        int dev = 0, cus = 0, per_cu = 0;
        hipGetDevice(&dev);
        hipDeviceGetAttribute(&cus, hipDeviceAttributeMultiprocessorCount, dev);
        hipOccupancyMaxActiveBlocksPerMultiprocessor(&per_cu, (const void*)k_mega, 512, 0);
        if (per_cu < 1) per_cu = 1;
        if (per_cu > 1) per_cu = 1;
        grid_blocks = cus * per_cu;
    }
    Params P{};
    const float** pp = (const float**)&P;
    for (int i = 0; i < 20; ++i) pp[i] = (const float*)d_in[i];
    P.out = (float*)d_out; P.ws = (unsigned char*)d_ws;
    void* args[] = {&P};
    hipError_t e = hipLaunchCooperativeKernel((const void*)k_mega, dim3(grid_blocks), dim3(512), args, 0, stream);
    if (e != hipSuccess) fprintf(stderr, "cooperative launch failed: %s (grid %d)\n", hipGetErrorString(e), grid_blocks);
}
```

```cpp
#include <hip/hip_runtime.h>
#include <hip/hip_cooperative_groups.h>
#include <cstdint>
#include <cstdio>
namespace cg = cooperative_groups;

constexpr int D = 2048, SEQ = 8192, NSAMP = 512, M = SEQ + NSAMP, INW = 5632, FFW = 8192, PLE = 256;
constexpr int DEC_B = 32, DEC_L = 16;
constexpr float EPS = 1e-6f;
constexpr size_t OFF_Y = 0;
constexpr size_t OFF_NKP = (size_t)M * D;
constexpr size_t OFF_NVP = OFF_NKP + 2 * 128 * 256;
constexpr size_t OFF_NSP = OFF_NVP + 2 * 128 * 256;
constexpr size_t OFF_NKS = OFF_NSP + 2 * 8 * 16384;
constexpr size_t OFF_NVS = OFF_NKS + 2 * 512 * 256;
constexpr size_t OFF_NSS = OFF_NVS + 2 * 512 * 256;
constexpr size_t MiB = 1u << 20;
constexpr size_t WS_H = 0;
constexpr size_t WS_UB = 68 * MiB;
constexpr size_t WS_MIXB = 102 * MiB;
constexpr size_t WS_BIG = 136 * MiB;
constexpr size_t WS_ORET = WS_BIG + 94 * MiB;
constexpr size_t WS_PBB = 272 * MiB;
constexpr size_t WS_CS = 281 * MiB;
constexpr size_t WS_W = 286 * MiB;
constexpr size_t WL_IN = 0, WL_OUT = 22 * MiB, WL_UP = 30 * MiB, WL_DOWN = 62 * MiB, WL_GATE = 94 * MiB, WL_PLE = 102 * MiB, WL_STRIDE = 103 * MiB;
constexpr int LDS_BYTES = 147456;

struct Params {
    const float *x_prompt, *x_sample, *cache_k, *cache_v, *state_ret, *p_prompt, *p_sample, *rel_bias, *norm_mix, *w_in, *attn_sink,
        *ret_gain, *w_out, *norm_mlp, *w_up, *w_down, *norm_ple, *w_gate, *w_ple, *norm_final;
    float* out; unsigned char* ws;
};


namespace pg8 {
#define PG8_LAS __attribute__((address_space(3)))
typedef unsigned short bf16_t;
typedef short bf16x8 __attribute__((ext_vector_type(8)));
typedef float f32x4 __attribute__((ext_vector_type(4)));
typedef unsigned u32x4 __attribute__((ext_vector_type(4)));
constexpr int BM = 256, BK = 64, HALF = 128, HTB = HALF * BK * 2  , STAGE_BYTES = 8 * HTB, NXCD = 8, WGM = 8;

__host__ __device__ __forceinline__ int lds_byte(int r, int c) { const int st = (r >> 4) * 2 + (c >> 5), rr = r & 15, cc = c & 31, ob = rr * 64 + cc * 2; return st * 1024 + (ob ^ (((ob >> 9) & 1) << 5)); }
__host__ __device__ __forceinline__ void stage_rc(int b, int& R, int& C) { const int st = b / 1024, sb = b % 1024, swz = sb ^ (((sb >> 9) & 1) << 5); R = (st >> 1) * 16 + swz / 64; C = (st & 1) * 32 + (swz % 64) / 2; }
__host__ __device__ __forceinline__ int perm32(int rho) { const int n = rho >> 4, i = rho & 15; return 8 * (i >> 2) + 4 * n + (i & 3); }

struct Unit { int pm, pn; };
struct Gemm { const bf16_t* A; const bf16_t* Bt; int M, N, K; };

struct StaticOrder {
    int nM, nN, nwg, G, c;
    __host__ __device__ void init(int M, int N, int G_, int c_) { nM = M / BM; nN = N / BM; nwg = nM * nN; G = G_; c = c_; }
    __host__ __device__ bool next(int i, Unit& u) const {
        const long L = (long)i * G + c; if (L >= nwg) return false;
        int wgid = (int)L; { const int q = nwg / NXCD, r = nwg % NXCD, xcd = wgid % NXCD, off = wgid / NXCD; wgid = (xcd < r ? xcd * (q + 1) : r * (q + 1) + (xcd - r) * q) + off; }
        const int nig = WGM * nN, gid = wgid / nig, fm = gid * WGM, gsz = (nM - fm) < WGM ? (nM - fm) : WGM;
        u.pm = fm + ((wgid % nig) % gsz); u.pn = (wgid % nig) / gsz; return true;
    }
    __device__ __forceinline__ void a_ready(const Unit&) const {}
    __device__ __forceinline__ void done(const Unit&) const {}
};


__device__ __forceinline__ unsigned cvt_pk_bf16(float lo, float hi) { unsigned r; asm volatile("v_cvt_pk_bf16_f32 %0, %1, %2" : "=v"(r) : "v"(lo), "v"(hi)); return r; }
typedef float f32x2 __attribute__((ext_vector_type(2)));

template <int ACT  > struct EpiBf16 {
    static constexpr bool PERM = true, AFTER_DRAIN = false;
    bf16_t* O; int ldc;
    __device__ __forceinline__ void operator()(const f32x4 (&acc)[2][2][4][2], const Unit& u, int wr, int wc, int fr, int fq) const {
        const int row0 = u.pm * BM + wr * 64 + fr, col0 = u.pn * BM + wc * 32 + 8 * fq;
#pragma unroll
        for (int ai = 0; ai < 2; ++ai)
#pragma unroll
            for (int m = 0; m < 4; ++m) { bf16_t* rowp = O + (size_t)(row0 + ai * HALF + m * 16) * ldc + col0;
#pragma unroll
                for (int bj = 0; bj < 2; ++bj) { f32x4 v0 = acc[ai][bj][m][0], v1 = acc[ai][bj][m][1];
                    if (ACT == 1) {
#pragma unroll
                        for (int j = 0; j < 4; ++j) { const float a = v0[j] > 0.f ? v0[j] : 0.f, b = v1[j] > 0.f ? v1[j] : 0.f; v0[j] = a * a; v1[j] = b * b; } }
                    u32x4 w; w.x = cvt_pk_bf16(v0[0], v0[1]); w.y = cvt_pk_bf16(v0[2], v0[3]); w.z = cvt_pk_bf16(v1[0], v1[1]); w.w = cvt_pk_bf16(v1[2], v1[3]);
                    *(u32x4*)(rowp + bj * HALF) = w; } }
    }
};
struct EpiProj {
    static constexpr bool PERM = true, AFTER_DRAIN = false;
    bf16_t* O; const float* CS; float* out; int layer;
    __device__ __forceinline__ void operator()(const f32x4 (&acc)[2][2][4][2], const Unit& u, int wr, int wc, int fr, int fq) const {
        const int pn = u.pn, row0 = u.pm * BM + wr * 64 + fr, col0 = pn * BM + wc * 32 + 8 * fq;
        const int kind = pn < 4 ? 0 : pn < 6 ? 1 : pn < 14 ? 2 : pn < 18 ? 0 : 3;
        const float rsc = (pn >= 10 && pn < 14) ? 0.08838834764831845f : 1.0f;
#pragma unroll
        for (int ai = 0; ai < 2; ++ai)
#pragma unroll
            for (int m = 0; m < 4; ++m) { const int row = row0 + ai * HALF + m * 16; bf16_t* rowp = O + (size_t)row * 5632 + col0;
                f32x4 cs0 = (f32x4){1.f, 0.f, 1.f, 0.f}, cs1 = cs0;
                if (kind == 2) { const int pos = row < 8192 ? row : 4096 + ((row - 8192) & 15); const float* cp = CS + ((size_t)pos * 64 + wc * 16 + fq * 4) * 2; cs0 = *(const f32x4*)cp; cs1 = *(const f32x4*)(cp + 4); }
#pragma unroll
                for (int bj = 0; bj < 2; ++bj) { f32x4 v0 = acc[ai][bj][m][0], v1 = acc[ai][bj][m][1];
                    if (kind == 2) {
                        f32x4 r0, r1;
                        r0[0] = (v0[0] * cs0[0] - v0[1] * cs0[1]) * rsc; r0[1] = (v0[1] * cs0[0] + v0[0] * cs0[1]) * rsc;
                        r0[2] = (v0[2] * cs0[2] - v0[3] * cs0[3]) * rsc; r0[3] = (v0[3] * cs0[2] + v0[2] * cs0[3]) * rsc;
                        r1[0] = (v1[0] * cs1[0] - v1[1] * cs1[1]) * rsc; r1[1] = (v1[1] * cs1[0] + v1[0] * cs1[1]) * rsc;
                        r1[2] = (v1[2] * cs1[2] - v1[3] * cs1[3]) * rsc; r1[3] = (v1[3] * cs1[2] + v1[2] * cs1[3]) * rsc;
                        v0 = r0; v1 = r1;
                    } else if (kind == 3) {
#pragma unroll
                        for (int j = 0; j < 4; ++j) { v0[j] = v0[j] / (1.f + __expf(-v0[j])); v1[j] = v1[j] / (1.f + __expf(-v1[j])); }
                    } else if (kind == 1) {
                        if (row >= 8064) { const int which = pn - 4;
                            float* dst = row < 8192 ? out + (which ? OFF_NVP : OFF_NKP) + (size_t)layer * 32768 + (size_t)(row - 8064) * 256
                                                    : out + (which ? OFF_NVS : OFF_NKS) + (size_t)layer * 131072 + (size_t)(row - 8192) * 256;
                            dst += bj * HALF + wc * 32 + 8 * fq; *(f32x4*)dst = v0; *(f32x4*)(dst + 4) = v1; }
                    }
                    u32x4 w; w.x = cvt_pk_bf16(v0[0], v0[1]); w.y = cvt_pk_bf16(v0[2], v0[3]); w.z = cvt_pk_bf16(v1[0], v1[1]); w.w = cvt_pk_bf16(v1[2], v1[3]);
                    *(u32x4*)(rowp + bj * HALF) = w; } }
    }
};
struct EpiRes {
    static constexpr bool PERM = false, AFTER_DRAIN = false;
    float* H;
    __device__ __forceinline__ void operator()(const f32x4 (&acc)[2][2][4][2], const Unit& u, int wr, int wc, int fr, int fq) const {
        const int row0 = u.pm * BM + wr * 64 + fr, col0 = u.pn * BM + wc * 32 + 4 * fq;
#pragma unroll
        for (int ai = 0; ai < 2; ++ai)
#pragma unroll
            for (int m = 0; m < 4; ++m) { float* rowp = H + (size_t)(row0 + ai * HALF + m * 16) * 2048 + col0;
#pragma unroll
                for (int bj = 0; bj < 2; ++bj)
#pragma unroll
                    for (int n = 0; n < 2; ++n) { f32x4* p = (f32x4*)(rowp + bj * HALF + n * 16); const f32x4 o = *p; *p = o + acc[ai][bj][m][n]; }
                asm volatile("" ::: "memory"); }
    }
};
struct EpiF32 {
    static constexpr bool PERM = false, AFTER_DRAIN = false;
    float* C;
    __device__ __forceinline__ void operator()(const f32x4 (&acc)[2][2][4][2], const Unit& u, int wr, int wc, int fr, int fq) const {
        const int row0 = u.pm * BM + wr * 64 + fr, col0 = u.pn * BM + wc * 32 + 4 * fq;
#pragma unroll
        for (int ai = 0; ai < 2; ++ai)
#pragma unroll
            for (int m = 0; m < 4; ++m) { float* rowp = C + (size_t)(row0 + ai * HALF + m * 16) * 2048 + col0;
#pragma unroll
                for (int bj = 0; bj < 2; ++bj)
#pragma unroll
                    for (int n = 0; n < 2; ++n) *(f32x4*)(rowp + bj * HALF + n * 16) = acc[ai][bj][m][n]; }
    }
};
struct EpiGate {
    static constexpr bool PERM = false, AFTER_DRAIN = false;
    float* H; const float* PL;
    __device__ __forceinline__ void operator()(const f32x4 (&acc)[2][2][4][2], const Unit& u, int wr, int wc, int fr, int fq) const {
        const int row0 = u.pm * BM + wr * 64 + fr, col0 = u.pn * BM + wc * 32 + 4 * fq;
#pragma unroll
        for (int ai = 0; ai < 2; ++ai)
#pragma unroll
            for (int m = 0; m < 4; ++m) { const size_t off = (size_t)(row0 + ai * HALF + m * 16) * 2048 + col0;
#pragma unroll
                for (int bj = 0; bj < 2; ++bj)
#pragma unroll
                    for (int n = 0; n < 2; ++n) { f32x4* p = (f32x4*)(H + off + bj * HALF + n * 16); const f32x4 pl = *(const f32x4*)(PL + off + bj * HALF + n * 16); const f32x4 a = acc[ai][bj][m][n]; f32x4 g;
#pragma unroll
                        for (int j = 0; j < 4; ++j) g[j] = 1.f / (1.f + __expf(-a[j]));
                        const f32x4 o = *p; *p = o + g * pl; }
                asm volatile("" ::: "memory"); }
    }
};


template <class Epi, class Sched, bool ALIGN_EPI = false, bool SP2 = false>
__device__ __forceinline__ void gemm_phase(PG8_LAS unsigned char* lds, const Gemm g, const Sched& S, const Epi& E, const int wave_s) {
    int tid_ = wave_s * 64 + (int)__builtin_amdgcn_mbcnt_hi(~0u, __builtin_amdgcn_mbcnt_lo(~0u, 0u)); asm volatile("" : "+v"(tid_));
    const int tid = tid_, wid = wave_s, lane = tid & 63, wr = wid >> 2, wc = wid & 3, fr = lane & 15, fq = lane >> 4;
    const int K = g.K, nt = K / BK;
    unsigned voffA[2], voffB[2];
#pragma unroll
    for (int i = 0; i < 2; ++i) { int R, C; stage_rc(tid * 16 + i * 8192, R, C); const int Rb = Epi::PERM ? ((R & ~31) + perm32(R & 31)) : R;
        voffA[i] = (unsigned)(R * K + C) * 2u; voffB[i] = (unsigned)(Rb * K + C) * 2u; }
    const size_t kstep = (size_t)(BK * 2);
    const size_t hstep = (size_t)HALF * K * 2;
    const size_t tstep = 2 * hstep;
    const unsigned ldsw = (unsigned)wid * 1024u;
    const int aoff = lds_byte(wr * 64 + fr, fq * 8), boff = lds_byte(wc * 32 + fr, fq * 8);
#define PG8_SA(b, h) (((b) * 2 + (h)) * HTB)
#define PG8_SB(b, h) ((4 + (b) * 2 + (h)) * HTB)
#define PG8_STAGE(bufoff, gbase, voff) do { _Pragma("unroll") for (int _i = 0; _i < 2; ++_i) \
        __builtin_amdgcn_global_load_lds((const unsigned*)((const char*)(gbase) + (voff)[_i]), (PG8_LAS unsigned*)(lds + (bufoff) + ldsw + _i * 8192), 16, 0, 0); } while (0)
#define PG8_LDA(dst, b, h) do { _Pragma("unroll") for (int m = 0; m < 4; ++m) _Pragma("unroll") for (int k = 0; k < 2; ++k) dst[m][k] = *(const PG8_LAS bf16x8*)(lds + PG8_SA(b, h) + aoff + m * 2048 + k * 1024); } while (0)
#define PG8_LDB(dst, b, h) do { _Pragma("unroll") for (int n = 0; n < 2; ++n) _Pragma("unroll") for (int k = 0; k < 2; ++k) dst[n][k] = *(const PG8_LAS bf16x8*)(lds + PG8_SB(b, h) + boff + n * 2048 + k * 1024); } while (0)
#define PG8_MMA(ai, bj, At, Bt) do { __builtin_amdgcn_s_setprio(1); _Pragma("unroll") for (int m = 0; m < 4; ++m) _Pragma("unroll") for (int n = 0; n < 2; ++n) _Pragma("unroll") for (int k = 0; k < 2; ++k) \
        acc[ai][bj][m][n] = __builtin_amdgcn_mfma_f32_16x16x32_bf16(Bt[n][k], At[m][k], acc[ai][bj][m][n], 0, 0, 0); __builtin_amdgcn_s_setprio(0); } while (0)
#define PG8_WAIT_V(n) asm volatile("s_waitcnt vmcnt(" #n ")" ::: "memory")
#define PG8_WAIT_L(n) asm volatile("s_waitcnt lgkmcnt(" #n ")" ::: "memory")
#define PG8_BAR __builtin_amdgcn_s_barrier()
#define PG8_SCHED __builtin_amdgcn_sched_barrier(0)
    Unit cur, nxt; int ui = 0;
    if (!S.next(0, cur)) return;
    f32x4 acc[2][2][4][2];
#pragma unroll
    for (int a = 0; a < 2; ++a)
#pragma unroll
        for (int b = 0; b < 2; ++b)
#pragma unroll
            for (int m = 0; m < 4; ++m)
#pragma unroll
                for (int n = 0; n < 2; ++n) acc[a][b][m][n] = (f32x4){0.f, 0.f, 0.f, 0.f};
    bf16x8 At[4][2], B0[2][2], B1[2][2];
    const char* cA = (const char*)g.A + (size_t)cur.pm * tstep; const char* cB = (const char*)g.Bt + (size_t)cur.pn * tstep;
    S.a_ready(cur);
    if constexpr (SP2) {
        PG8_STAGE(PG8_SB(0, 0), cB, voffB); PG8_STAGE(PG8_SB(0, 1), cB + hstep, voffB); PG8_STAGE(PG8_SA(0, 0), cA, voffA); PG8_STAGE(PG8_SA(0, 1), cA + hstep, voffA);
        if (wr == 1) PG8_BAR;
        PG8_WAIT_V(2); PG8_BAR;
        PG8_STAGE(PG8_SB(1, 0), cB + kstep, voffB); PG8_STAGE(PG8_SA(1, 0), cA + kstep, voffA); PG8_STAGE(PG8_SB(1, 1), cB + hstep + kstep, voffB);
        PG8_WAIT_V(6); PG8_BAR;
    } else {
        PG8_STAGE(PG8_SB(0, 0), cB, voffB); PG8_STAGE(PG8_SA(0, 0), cA, voffA); PG8_STAGE(PG8_SB(0, 1), cB + hstep, voffB); PG8_STAGE(PG8_SA(0, 1), cA + hstep, voffA);
        if (wr == 1) PG8_BAR;
        PG8_WAIT_V(4); PG8_BAR;
        PG8_STAGE(PG8_SB(1, 0), cB + kstep, voffB); PG8_STAGE(PG8_SA(1, 0), cA + kstep, voffA); PG8_STAGE(PG8_SB(1, 1), cB + hstep + kstep, voffB);
        PG8_WAIT_V(6); PG8_BAR;
    }
    for (;;) {
        const bool has_next = S.next(ui + 1, nxt);
        const char* nA = has_next ? (const char*)g.A + (size_t)nxt.pm * tstep : cA; const char* nB = has_next ? (const char*)g.Bt + (size_t)nxt.pn * tstep : cB;
        for (int t = 0; t < nt; t += 2) {
            const bool last = (t == nt - 2);
            const char* a1 = cA + (size_t)(t + 1) * kstep;
            const char* a2 = last ? nA : cA + (size_t)(t + 2) * kstep; const char* b2 = last ? nB : cB + (size_t)(t + 2) * kstep;
            const char* a3 = a2 + kstep; const char* b3 = b2 + kstep;
            if (last && has_next) S.a_ready(nxt);
            if constexpr (SP2) {
            PG8_LDB(B0, 0, 0); PG8_LDB(B1, 0, 1); PG8_SCHED; PG8_LDA(At, 0, 0); PG8_STAGE(PG8_SA(1, 1), a1 + hstep, voffA);
            PG8_WAIT_V(8); PG8_WAIT_L(0); PG8_BAR; PG8_MMA(0, 0, At, B0); PG8_MMA(0, 1, At, B1); PG8_BAR; PG8_SCHED;
            PG8_LDA(At, 0, 1); PG8_STAGE(PG8_SB(0, 0), b2, voffB); PG8_STAGE(PG8_SB(0, 1), b2 + hstep, voffB); PG8_STAGE(PG8_SA(0, 0), a2, voffA);
            PG8_WAIT_V(8); PG8_WAIT_L(0); PG8_BAR; PG8_MMA(1, 0, At, B0); PG8_MMA(1, 1, At, B1); PG8_BAR; PG8_SCHED;
            PG8_LDB(B0, 1, 0); PG8_LDB(B1, 1, 1); PG8_SCHED; PG8_LDA(At, 1, 0); PG8_STAGE(PG8_SA(0, 1), a2 + hstep, voffA);
            PG8_WAIT_V(8); PG8_WAIT_L(0); PG8_BAR; PG8_MMA(0, 0, At, B0); PG8_MMA(0, 1, At, B1); PG8_BAR; PG8_SCHED;
            PG8_LDA(At, 1, 1); PG8_STAGE(PG8_SB(1, 0), b3, voffB); PG8_STAGE(PG8_SB(1, 1), b3 + hstep, voffB); PG8_STAGE(PG8_SA(1, 0), a3, voffA);
            PG8_WAIT_V(8); PG8_WAIT_L(0); PG8_BAR; PG8_MMA(1, 0, At, B0); PG8_MMA(1, 1, At, B1); PG8_BAR; PG8_SCHED;
            } else {
            PG8_LDB(B0, 0, 0); PG8_SCHED; PG8_LDA(At, 0, 0); PG8_STAGE(PG8_SA(1, 1), a1 + hstep, voffA);
            PG8_WAIT_L(8); PG8_BAR; PG8_WAIT_L(0); PG8_MMA(0, 0, At, B0); PG8_BAR; PG8_SCHED;
            PG8_LDB(B1, 0, 1); PG8_STAGE(PG8_SB(0, 0), b2, voffB);
            PG8_BAR; PG8_WAIT_L(0); PG8_MMA(0, 1, At, B1); PG8_BAR;
            PG8_LDA(At, 0, 1); PG8_STAGE(PG8_SA(0, 0), a2, voffA);
            PG8_BAR; PG8_WAIT_L(0); PG8_MMA(1, 0, At, B0); PG8_BAR; PG8_SCHED;
            PG8_STAGE(PG8_SB(0, 1), b2 + hstep, voffB);
            PG8_WAIT_V(6); PG8_BAR; PG8_MMA(1, 1, At, B1); PG8_BAR;
            PG8_LDB(B0, 1, 0); PG8_SCHED; PG8_LDA(At, 1, 0); PG8_STAGE(PG8_SA(0, 1), a2 + hstep, voffA);
            PG8_WAIT_L(8); PG8_BAR; PG8_WAIT_L(0); PG8_MMA(0, 0, At, B0); PG8_BAR; PG8_SCHED;
            PG8_LDB(B1, 1, 1); PG8_STAGE(PG8_SB(1, 0), b3, voffB);
            PG8_BAR; PG8_WAIT_L(0); PG8_MMA(0, 1, At, B1); PG8_BAR;
            PG8_LDA(At, 1, 1); PG8_STAGE(PG8_SA(1, 0), a3, voffA);
            PG8_BAR; PG8_WAIT_L(0); PG8_MMA(1, 0, At, B0); PG8_BAR; PG8_SCHED;
            PG8_STAGE(PG8_SB(1, 1), b3 + hstep, voffB);
            PG8_WAIT_V(6); PG8_BAR; PG8_MMA(1, 1, At, B1); PG8_BAR;
            }
        }
        if constexpr (ALIGN_EPI) { if (wr == 0) PG8_BAR; }
        if constexpr (!Epi::AFTER_DRAIN) { E(acc, cur, wr, wc, fr, fq); S.done(cur); }
        if (!has_next) break;
#pragma unroll
        for (int a = 0; a < 2; ++a)
#pragma unroll
            for (int b = 0; b < 2; ++b)
#pragma unroll
                for (int m = 0; m < 4; ++m)
#pragma unroll
                    for (int n = 0; n < 2; ++n) acc[a][b][m][n] = (f32x4){0.f, 0.f, 0.f, 0.f};
        cur = nxt; cA = nA; cB = nB; ++ui;
        if constexpr (ALIGN_EPI) { if (wr == 1) PG8_BAR; }
    }
    PG8_WAIT_V(0);
    if constexpr (!ALIGN_EPI) { if (wr == 0) PG8_BAR; }
    PG8_BAR;
    if constexpr (Epi::AFTER_DRAIN) { E.fused(acc, cur, wr, wc, fr, fq, lds, wid, lane); S.done(cur); }
#undef PG8_SA
#undef PG8_SB
#undef PG8_STAGE
#undef PG8_LDA
#undef PG8_LDB
#undef PG8_MMA
#undef PG8_WAIT_V
#undef PG8_WAIT_L
#undef PG8_BAR
#undef PG8_SCHED
}
}

#define LAS __attribute__((address_space(3)))
typedef unsigned short bf16;
typedef float f32x4 __attribute__((ext_vector_type(4)));
typedef unsigned v4u __attribute__((ext_vector_type(4)));
#define LDS_WAIT() asm volatile("s_waitcnt lgkmcnt(0)" ::: "memory")
__device__ __forceinline__ int opaque_tid(int wave_s) { int t = wave_s * 64 + (int)__builtin_amdgcn_mbcnt_hi(~0u, __builtin_amdgcn_mbcnt_lo(~0u, 0u)); asm volatile("" : "+v"(t)); return t; }
__device__ __forceinline__ unsigned f2bf(float f) { unsigned u = __builtin_bit_cast(unsigned, f); return (u + 0x7fffu + ((u >> 16) & 1u)) >> 16; }
__device__ __forceinline__ unsigned pk2(float lo, float hi) { return f2bf(lo) | (f2bf(hi) << 16); }
__device__ __forceinline__ float bf2f(unsigned x) { return __uint_as_float(x << 16); }
__device__ __forceinline__ float wave_sum(float v) {
#pragma unroll
    for (int o = 1; o < 64; o <<= 1) v += __shfl_xor(v, o);
    return v;
}
__device__ __forceinline__ int t5_bucket(int rel) {
    const int ret = rel > 0 ? 16 : 0; const int n = rel < 0 ? -rel : rel;
    if (n < 8) return ret + n;
    const int v = (n * n) >> 6; int lg = 31 - __clz(v); int large = 8 + lg; if (large > 15) large = 15;
    return ret + large;
}
__device__ __forceinline__ int in_src_col(int n) {
    if (n < 1536 || n >= 3584) return n;
    const int base = n < 2560 ? 1536 : 2560, rel = n - base, s = rel & 127;
    return base + (rel & ~127) + (s >> 1) + 64 * (s & 1);
}
__device__ __forceinline__ void conv_item(const float* W, int K, int N, bf16* WT, LAS float* scr, int item, int lane, bool perm_in) {
    const int nblk = N / 32, kb = item / nblk, nb = item % nblk, k0 = 64 * kb, n0 = 32 * nb;
    int nsrc = n0 + (lane & 31); if (perm_in) nsrc = in_src_col(nsrc);
#pragma unroll 8
    for (int i = 0; i < 32; ++i) { const int kk = 2 * i + (lane >> 5); scr[kk * 33 + (lane & 31)] = W[(size_t)(k0 + kk) * N + nsrc]; }
    LDS_WAIT(); asm volatile("" ::: "memory");
    const int c = lane & 7;
#pragma unroll
    for (int j = 0; j < 4; ++j) { const int n = (lane >> 3) + 8 * j; const LAS float* s = scr + (8 * c) * 33 + n;
        v4u o; o.x = pk2(s[0 * 33], s[1 * 33]); o.y = pk2(s[2 * 33], s[3 * 33]); o.z = pk2(s[4 * 33], s[5 * 33]); o.w = pk2(s[6 * 33], s[7 * 33]);
        *(v4u*)(WT + (size_t)(n0 + n) * K + k0 + 8 * c) = o; }
    LDS_WAIT(); asm volatile("" ::: "memory");
}
__device__ __forceinline__ void rms_row_bf16(const float* xrow, const float* g, bf16* yrow, float* hcopy, int lane) {
    const f32x4* xr = (const f32x4*)xrow + lane; f32x4 v[8]; float s = 0.f;
#pragma unroll
    for (int j = 0; j < 8; ++j) { v[j] = xr[64 * j]; s += (v[j].x * v[j].x + v[j].y * v[j].y) + (v[j].z * v[j].z + v[j].w * v[j].w); }
    const float rs = rsqrtf(wave_sum(s) * (1.f / D) + EPS);
    if (hcopy) { f32x4* hr = (f32x4*)hcopy + lane;
#pragma unroll
        for (int j = 0; j < 8; ++j) hr[64 * j] = v[j]; }
    const f32x4* gr = (const f32x4*)g + lane; uint2* yr = (uint2*)yrow + lane;
#pragma unroll
    for (int j = 0; j < 8; ++j) { const f32x4 gg = gr[64 * j]; uint2 w; w.x = pk2(v[j].x * rs * gg.x, v[j].y * rs * gg.y); w.y = pk2(v[j].z * rs * gg.z, v[j].w * rs * gg.w); yr[64 * j] = w; }
}
__device__ __forceinline__ void ph_rmsnorm_bf16(const Params& P, const float* g, int wave_s) {
    const float* H = (const float*)(P.ws + WS_H); bf16* UB = (bf16*)(P.ws + WS_UB);
    const int tid = opaque_tid(wave_s); const int lane = tid & 63, gw = blockIdx.x * 8 + (tid >> 6), ngw = gridDim.x * 8;
    for (int r = gw; r < M; r += ngw) rms_row_bf16(H + (size_t)r * D, g, UB + (size_t)r * D, nullptr, lane);
}
__device__ __forceinline__ void ph_final_norm(const Params& P, int wave_s) {
    const float* H = (const float*)(P.ws + WS_H);
    const int tid = opaque_tid(wave_s); const int lane = tid & 63, gw = blockIdx.x * 8 + (tid >> 6), ngw = gridDim.x * 8;
    for (int r = gw; r < M; r += ngw) {
        const f32x4* xr = (const f32x4*)(H + (size_t)r * D) + lane; f32x4 v[8]; float s = 0.f;
#pragma unroll
        for (int j = 0; j < 8; ++j) { v[j] = xr[64 * j]; s += (v[j].x * v[j].x + v[j].y * v[j].y) + (v[j].z * v[j].z + v[j].w * v[j].w); }
        const float rs = rsqrtf(wave_sum(s) * (1.f / D) + EPS);
        f32x4* yr = (f32x4*)(P.out + OFF_Y + (size_t)r * D) + lane; const f32x4* gr = (const f32x4*)P.norm_final + lane;
#pragma unroll
        for (int j = 0; j < 8; ++j) yr[64 * j] = v[j] * rs * gr[64 * j];
    }
}
__device__ __forceinline__ void ph_prologue(const Params& P, LAS unsigned char* lds, int wave_s) {
    const int tid = opaque_tid(wave_s), lane = tid & 63, wave = tid >> 6;
    const int gw = blockIdx.x * 8 + wave, ngw = gridDim.x * 8;
    LAS float* scr = (LAS float*)(lds + wave * 16384);
    constexpr int I_IN = 32 * 176, I_OUT = 32 * 64, I_UP = 32 * 256, I_DOWN = 128 * 64, I_GATE = 32 * 64, I_PLE = 4 * 64, I_L = I_IN + I_OUT + I_UP + I_DOWN + I_GATE + I_PLE;
    for (int it = gw; it < 2 * I_L; it += ngw) {
        const int l = it / I_L; int r = it % I_L; unsigned char* wl = P.ws + WS_W + (size_t)l * WL_STRIDE;
        if (r < I_IN) { conv_item(P.w_in + (size_t)l * D * INW, D, INW, (bf16*)(wl + WL_IN), scr, r, lane, true); continue; } r -= I_IN;
        if (r < I_OUT) { conv_item(P.w_out + (size_t)l * D * D, D, D, (bf16*)(wl + WL_OUT), scr, r, lane, false); continue; } r -= I_OUT;
        if (r < I_UP) { conv_item(P.w_up + (size_t)l * D * FFW, D, FFW, (bf16*)(wl + WL_UP), scr, r, lane, false); continue; } r -= I_UP;
        if (r < I_DOWN) { conv_item(P.w_down + (size_t)l * FFW * D, FFW, D, (bf16*)(wl + WL_DOWN), scr, r, lane, false); continue; } r -= I_DOWN;
        if (r < I_GATE) { conv_item(P.w_gate + (size_t)l * D * D, D, D, (bf16*)(wl + WL_GATE), scr, r, lane, false); continue; } r -= I_GATE;
        conv_item(P.w_ple + (size_t)l * PLE * D, PLE, D, (bf16*)(wl + WL_PLE), scr, r, lane, false);
    }
    float* H = (float*)(P.ws + WS_H); bf16* UB = (bf16*)(P.ws + WS_UB);
    for (int r = gw; r < M; r += ngw) {
        const float* xrow = r < SEQ ? P.x_prompt + (size_t)r * D : P.x_sample + (size_t)(r - SEQ) * D;
        rms_row_bf16(xrow, P.norm_mix, UB + (size_t)r * D, H + (size_t)r * D, lane);
    }
    const size_t gt = (size_t)blockIdx.x * 512 + tid, gs = (size_t)gridDim.x * 512;
    bf16* PBB = (bf16*)(P.ws + WS_PBB);
    for (size_t i = gt; i < (size_t)2 * M * PLE / 4; i += gs) {
        const size_t e = i * 4; const int l = (int)(e / ((size_t)M * PLE)); const size_t r = e % ((size_t)M * PLE); f32x4 v;
        if (r < (size_t)SEQ * PLE) v = *(const f32x4*)(P.p_prompt + (size_t)l * SEQ * PLE + r); else v = *(const f32x4*)(P.p_sample + (size_t)l * NSAMP * PLE + (r - (size_t)SEQ * PLE));
        uint2 w; w.x = pk2(v.x, v.y); w.y = pk2(v.z, v.w); *(uint2*)(PBB + e) = w;
    }
    float* CS = (float*)(P.ws + WS_CS);
    for (size_t i = gt; i < (size_t)SEQ * 64; i += gs) {
        const int pos = (int)(i >> 6), d = (int)(i & 63);
        const double inv = pow(10000.0, -(double)d / 64.0); const double ang = (double)pos * inv;
        CS[2 * i] = (float)cos(ang); CS[2 * i + 1] = (float)sin(ang);
    }
}

__device__ __forceinline__ void ld16_bf16(const bf16* p, f32x4 (&o)[4]) {
    const v4u a = *(const v4u*)p, b = *(const v4u*)(p + 8);
    o[0] = (f32x4){bf2f(a.x & 0xffffu), bf2f(a.x >> 16), bf2f(a.y & 0xffffu), bf2f(a.y >> 16)}; o[1] = (f32x4){bf2f(a.z & 0xffffu), bf2f(a.z >> 16), bf2f(a.w & 0xffffu), bf2f(a.w >> 16)};
    o[2] = (f32x4){bf2f(b.x & 0xffffu), bf2f(b.x >> 16), bf2f(b.y & 0xffffu), bf2f(b.y >> 16)}; o[3] = (f32x4){bf2f(b.z & 0xffffu), bf2f(b.z >> 16), bf2f(b.w & 0xffffu), bf2f(b.w >> 16)};
}
__device__ __forceinline__ void ld16_f32(const float* p, f32x4 (&o)[4]) {
#pragma unroll
    for (int j = 0; j < 4; ++j) o[j] = *(const f32x4*)(p + 4 * j);
}
__device__ __forceinline__ void ph_attn_naive(const Params& P, int l, int wave_s) {
    const bf16* PROJ = (const bf16*)(P.ws + WS_BIG); bf16* MIXB = (bf16*)(P.ws + WS_MIXB);
    const int nP = SEQ * 16 * 4, nS = NSAMP * 16 * 4;
    const int tid = opaque_tid(wave_s);
    for (int it = blockIdx.x * 512 + tid; it < nP + nS; it += gridDim.x * 512) {
        const bool sample = it >= nP; int row, hq, c = 0, b = 0, qi = 0; const int part = it & 3;
        if (!sample) { const int q = (it >> 2) & 63; hq = (it >> 8) & 15; c = it >> 12; row = c * 64 + q; }
        else { const int j = it - nP; qi = (j >> 2) & 15; hq = (j >> 6) & 15; b = j >> 10; row = SEQ + b * 16 + qi; }
        const int kh = hq >> 2; const float sink = P.attn_sink[l * 16 + hq];
        f32x4 q[4], acc[4];
        ld16_bf16(PROJ + (size_t)row * INW + hq * 64 + part * 16, q);
#pragma unroll
        for (int d4 = 0; d4 < 4; ++d4) acc[d4] = (f32x4){0.f, 0.f, 0.f, 0.f};
        float m = sink, ls = 1.f;
        const int nk = sample ? 144 : 192;
#pragma unroll 1
        for (int s = 0; s < nk; ++s) {
            f32x4 kk[4], vv[4]; int rel;
            if (!sample) { const int kpos = c * 64 - 128 + s; if (kpos < 0) continue; rel = kpos - row;
                const bf16* kp = PROJ + (size_t)kpos * INW + 1024 + kh * 64 + part * 16; ld16_bf16(kp, kk); ld16_bf16(kp + 256, vv); }
            else { rel = s - 128 - qi;
                if (s < 128) { const size_t o = ((((size_t)l * DEC_B + b) * 128 + s) * 4 + kh) * 64 + part * 16; ld16_f32(P.cache_k + o, kk); ld16_f32(P.cache_v + o, vv); }
                else { const bf16* kp = PROJ + (size_t)(SEQ + b * 16 + (s - 128)) * INW + 1024 + kh * 64 + part * 16; ld16_bf16(kp, kk); ld16_bf16(kp + 256, vv); } }
            float dot = 0.f;
#pragma unroll
            for (int d4 = 0; d4 < 4; ++d4) dot += (q[d4].x * kk[d4].x + q[d4].y * kk[d4].y) + (q[d4].z * kk[d4].z + q[d4].w * kk[d4].w);
            dot += __shfl_xor(dot, 1); dot += __shfl_xor(dot, 2);
            const float sc = dot * 0.125f + P.rel_bias[t5_bucket(rel) * 16 + hq];
            const float mn = fmaxf(m, sc), corr = __expf(m - mn), p = __expf(sc - mn);
            ls = ls * corr + p; m = mn;
#pragma unroll
            for (int d4 = 0; d4 < 4; ++d4) acc[d4] = acc[d4] * corr + vv[d4] * p;
        }
        const float inv = 1.f / ls;
        v4u w0, w1;
        w0.x = pk2(acc[0].x * inv, acc[0].y * inv); w0.y = pk2(acc[0].z * inv, acc[0].w * inv); w0.z = pk2(acc[1].x * inv, acc[1].y * inv); w0.w = pk2(acc[1].z * inv, acc[1].w * inv);
        w1.x = pk2(acc[2].x * inv, acc[2].y * inv); w1.y = pk2(acc[2].z * inv, acc[2].w * inv); w1.z = pk2(acc[3].x * inv, acc[3].y * inv); w1.w = pk2(acc[3].z * inv, acc[3].w * inv);
        bf16* op = MIXB + (size_t)row * D + hq * 64 + part * 16; *(v4u*)op = w0; *(v4u*)(op + 8) = w1;
    }
}
__device__ __forceinline__ void ph_ret_naive(const Params& P, int l, LAS unsigned char* lds, int wave_s) {
    const bf16* PROJ = (const bf16*)(P.ws + WS_BIG); float* ORET = (float*)(P.ws + WS_ORET);
    LAS float* sq = (LAS float*)lds; LAS float* sk = sq + 16 * 128; LAS float* so = sk + 16 * 128;
    const int tid = opaque_tid(wave_s);
    for (int it = blockIdx.x; it < 33 * 8; it += gridDim.x) {
        const int seq = it >> 3, h = it & 7; const int len = seq == 0 ? SEQ : 16; const int row0 = seq == 0 ? 0 : SEQ + (seq - 1) * 16;
        const float gamma = 1.f - exp2f(-5.f - (float)h);
        float S[64]; const int e = tid & 127, half = (tid >> 7) & 1;
        if (seq == 0) {
#pragma unroll
            for (int d = 0; d < 64; ++d) S[d] = 0.f;
        } else {
            const float* s0 = P.state_ret + (((size_t)l * DEC_B + (seq - 1)) * 8 + h) * 16384;
#pragma unroll
            for (int d = 0; d < 64; ++d) { const int s = half * 64 + d, od = (s >> 1) + 64 * (s & 1); S[d] = s0[od * 128 + e]; }
        }
        for (int t0 = 0; t0 < len; t0 += 16) {
            __syncthreads();
            for (int i = tid; i < 4096; i += 512) { const int tt = i >> 8, dd = i & 255, which = dd >> 7, d = dd & 127;
                const float v = bf2f(PROJ[(size_t)(row0 + t0 + tt) * INW + (which ? 2560 : 1536) + h * 128 + d]); (which ? sk : sq)[tt * 128 + d] = v; }
            __syncthreads();
            if (tid < 256) {
#pragma unroll 1
                for (int tt = 0; tt < 16; ++tt) {
                    const float v = bf2f(PROJ[(size_t)(row0 + t0 + tt) * INW + 3584 + h * 128 + e]); float o = 0.f;
#pragma unroll
                    for (int d = 0; d < 64; ++d) { S[d] = gamma * S[d] + sk[tt * 128 + half * 64 + d] * v; o += sq[tt * 128 + half * 64 + d] * S[d]; }
                    so[(tt * 2 + half) * 128 + e] = o;
                }
            }
            __syncthreads();
            for (int i = tid; i < 2048; i += 512) { const int tt = i >> 7, ee = i & 127;
                ORET[(size_t)(row0 + t0 + tt) * 1024 + h * 128 + ee] = so[(tt * 2) * 128 + ee] + so[(tt * 2 + 1) * 128 + ee]; }
        }
        if (tid < 256) {
            float* sp = P.out + (seq == 0 ? OFF_NSP + ((size_t)l * 8 + h) * 16384 : OFF_NSS + (((size_t)l * DEC_B + (seq - 1)) * 8 + h) * 16384);
#pragma unroll
            for (int d = 0; d < 64; ++d) { const int s = half * 64 + d, od = (s >> 1) + 64 * (s & 1); sp[od * 128 + e] = S[d]; }
        }
    }
}
__device__ __forceinline__ void ph_ret_finish(const Params& P, int l, int wave_s) {
    const bf16* PROJ = (const bf16*)(P.ws + WS_BIG); const float* ORET = (const float*)(P.ws + WS_ORET); bf16* MIXB = (bf16*)(P.ws + WS_MIXB);
    const int tid = opaque_tid(wave_s); const int lane = tid & 63, gw = blockIdx.x * 8 + (tid >> 6), ngw = gridDim.x * 8;
    for (int it = gw; it < M * 8; it += ngw) {
        const int row = it >> 3, h = it & 7;
        const float o0 = ORET[(size_t)row * 1024 + h * 128 + lane], o1 = ORET[(size_t)row * 1024 + h * 128 + 64 + lane];
        const float rs = rsqrtf(wave_sum(o0 * o0 + o1 * o1) * (1.f / 128.f) + EPS);
        const float g0 = bf2f(PROJ[(size_t)row * INW + 4608 + h * 128 + lane]), g1 = bf2f(PROJ[(size_t)row * INW + 4608 + h * 128 + 64 + lane]);
        const float gn0 = P.ret_gain[l * 1024 + h * 128 + lane], gn1 = P.ret_gain[l * 1024 + h * 128 + 64 + lane];
        MIXB[(size_t)row * D + 1024 + h * 128 + lane] = (bf16)f2bf(g0 * (o0 * rs * gn0));
        MIXB[(size_t)row * D + 1024 + h * 128 + 64 + lane] = (bf16)f2bf(g1 * (o1 * rs * gn1));
    }
}

#define GEMM_PHASE(EPI, ...) pg8::gemm_phase<EPI, pg8::StaticOrder, true, true>(lds, g, S, E, wave_s)
template <int l> __device__ __forceinline__ void layer_body(const Params& P, LAS unsigned char* lds, cg::grid_group& grid, int wave_s) {
    const int G = gridDim.x, bx = blockIdx.x;
    float* H = (float*)(P.ws + WS_H); bf16* UB = (bf16*)(P.ws + WS_UB); bf16* MIXB = (bf16*)(P.ws + WS_MIXB);
    bf16* PROJB = (bf16*)(P.ws + WS_BIG); bf16* FFB = (bf16*)(P.ws + WS_BIG); float* PL = (float*)(P.ws + WS_BIG); bf16* PBB = (bf16*)(P.ws + WS_PBB);
    const float* CS = (const float*)(P.ws + WS_CS);
    const unsigned char* wl = P.ws + WS_W + (size_t)l * WL_STRIDE;
    if (l > 0) { ph_rmsnorm_bf16(P, P.norm_mix + l * D, wave_s); grid.sync(); }
#ifndef NO_P1
    { pg8::Gemm g{UB, (const bf16*)(wl + WL_IN), M, INW, D}; pg8::StaticOrder S; S.init(M, INW, G, bx); pg8::EpiProj E{PROJB, CS, P.out, l}; GEMM_PHASE(pg8::EpiProj); }
#endif
    grid.sync();
#ifndef NO_P2
    ph_attn_naive(P, l, wave_s);
#endif
#ifndef NO_P3
    ph_ret_naive(P, l, lds, wave_s);
#endif
    grid.sync();
    ph_ret_finish(P, l, wave_s); grid.sync();
#ifndef NO_P4
    { pg8::Gemm g{MIXB, (const bf16*)(wl + WL_OUT), M, D, D}; pg8::StaticOrder S; S.init(M, D, G, bx); pg8::EpiRes E{H}; GEMM_PHASE(pg8::EpiRes); }
#endif
    grid.sync();
    ph_rmsnorm_bf16(P, P.norm_mlp + l * D, wave_s); grid.sync();
#ifndef NO_P5
    { pg8::Gemm g{UB, (const bf16*)(wl + WL_UP), M, FFW, D}; pg8::StaticOrder S; S.init(M, FFW, G, bx); pg8::EpiBf16<1> E{FFB, FFW}; GEMM_PHASE(pg8::EpiBf16<1>); }
#endif
    grid.sync();
#ifndef NO_P6
    { pg8::Gemm g{FFB, (const bf16*)(wl + WL_DOWN), M, D, FFW}; pg8::StaticOrder S; S.init(M, D, G, bx); pg8::EpiRes E{H}; GEMM_PHASE(pg8::EpiRes); }
#endif
    grid.sync();
    ph_rmsnorm_bf16(P, P.norm_ple + l * D, wave_s); grid.sync();
#ifndef NO_P7
    { pg8::Gemm g{PBB + (size_t)l * M * PLE, (const bf16*)(wl + WL_PLE), M, D, PLE}; pg8::StaticOrder S; S.init(M, D, G, bx); pg8::EpiF32 E{PL}; GEMM_PHASE(pg8::EpiF32); }
#endif
#ifndef NO_P8
    { pg8::Gemm g{UB, (const bf16*)(wl + WL_GATE), M, D, D}; pg8::StaticOrder S; S.init(M, D, G, bx); pg8::EpiGate E{H, PL}; GEMM_PHASE(pg8::EpiGate); }
#endif
    grid.sync();
}
__global__ void __launch_bounds__(512, 2) k_mega(Params P) {
    extern __shared__ __attribute__((aligned(16))) unsigned char lds_raw[];
    LAS unsigned char* lds = (LAS unsigned char*)lds_raw;
    cg::grid_group grid = cg::this_grid();
    const int wave_s = __builtin_amdgcn_readfirstlane((int)(threadIdx.x >> 6));
#ifndef NO_P0
    ph_prologue(P, lds, wave_s);
#endif
    grid.sync();
    layer_body<0>(P, lds, grid, wave_s);
    layer_body<1>(P, lds, grid, wave_s);
    ph_final_norm(P, wave_s);
}

extern "C" void kernel_launch(void* const* d_in, const int* in_sizes, int n_in, void* d_out, int out_size, void* d_ws, size_t ws_size, hipStream_t stream) {
    static int grid_blocks = 0;
    if (!grid_blocks) {
        int dev = 0, cus = 0, per_cu = 0;
        (void)hipGetDevice(&dev);
        (void)hipDeviceGetAttribute(&cus, hipDeviceAttributeMultiprocessorCount, dev);
        (void)hipFuncSetAttribute((const void*)k_mega, hipFuncAttributeMaxDynamicSharedMemorySize, LDS_BYTES);
        (void)hipOccupancyMaxActiveBlocksPerMultiprocessor(&per_cu, (const void*)k_mega, 512, LDS_BYTES);
        if (per_cu != 1) fprintf(stderr, "kernel_launch: occupancy query says %d blocks per CU (expected 1)\n", per_cu);
        grid_blocks = cus;
        if (ws_size < WS_W + 2 * WL_STRIDE) fprintf(stderr, "kernel_launch: workspace too small: %zu\n", ws_size);
    }
    Params P{};
    const float** pp = (const float**)&P;
    for (int i = 0; i < 20; ++i) pp[i] = (const float*)d_in[i];
    P.out = (float*)d_out; P.ws = (unsigned char*)d_ws;
    void* args[] = {&P};
    hipError_t e = hipLaunchCooperativeKernel((const void*)k_mega, dim3(grid_blocks), dim3(512), args, LDS_BYTES, stream);
    if (e != hipSuccess) fprintf(stderr, "cooperative launch failed: %s (grid %d)\n", hipGetErrorString(e), grid_blocks);
}
```

```cpp
#include <hip/hip_runtime.h>
#include <hip/hip_cooperative_groups.h>
#include <cstdint>
#include <cstdio>
namespace cg = cooperative_groups;

constexpr int D = 2048, SEQ = 8192, NSAMP = 512, M = SEQ + NSAMP, INW = 5632, FFW = 8192, PLE = 256;
constexpr int DEC_B = 32, DEC_L = 16;
constexpr float EPS = 1e-6f;
constexpr size_t OFF_Y = 0;
constexpr size_t OFF_NKP = (size_t)M * D;
constexpr size_t OFF_NVP = OFF_NKP + 2 * 128 * 256;
constexpr size_t OFF_NSP = OFF_NVP + 2 * 128 * 256;
constexpr size_t OFF_NKS = OFF_NSP + 2 * 8 * 16384;
constexpr size_t OFF_NVS = OFF_NKS + 2 * 512 * 256;
constexpr size_t OFF_NSS = OFF_NVS + 2 * 512 * 256;
constexpr size_t MiB = 1u << 20;
constexpr size_t WS_H = 0;
constexpr size_t WS_UB = 68 * MiB;
constexpr size_t WS_MIXB = 102 * MiB;
constexpr size_t WS_BIG = 136 * MiB;
constexpr size_t WS_UPD = WS_BIG + 94 * MiB;
constexpr size_t WS_PBB = 272 * MiB;
constexpr size_t WS_CS = 281 * MiB;
constexpr size_t WS_W = 286 * MiB;
constexpr size_t WL_IN = 0, WL_OUT = 22 * MiB, WL_UP = 30 * MiB, WL_DOWN = 62 * MiB, WL_GATE = 94 * MiB, WL_PLE = 102 * MiB, WL_STRIDE = 103 * MiB;
constexpr int LDS_BYTES = 147456;

struct Params {
    const float *x_prompt, *x_sample, *cache_k, *cache_v, *state_ret, *p_prompt, *p_sample, *rel_bias, *norm_mix, *w_in, *attn_sink,
        *ret_gain, *w_out, *norm_mlp, *w_up, *w_down, *norm_ple, *w_gate, *w_ple, *norm_final;
    float* out; unsigned char* ws;
};


namespace pg8 {
#define PG8_LAS __attribute__((address_space(3)))
typedef unsigned short bf16_t;
typedef short bf16x8 __attribute__((ext_vector_type(8)));
typedef float f32x4 __attribute__((ext_vector_type(4)));
typedef unsigned u32x4 __attribute__((ext_vector_type(4)));
constexpr int BM = 256, BK = 64, HALF = 128, HTB = HALF * BK * 2  , STAGE_BYTES = 8 * HTB, NXCD = 8, WGM = 8;

__host__ __device__ __forceinline__ int lds_byte(int r, int c) { const int st = (r >> 4) * 2 + (c >> 5), rr = r & 15, cc = c & 31, ob = rr * 64 + cc * 2; return st * 1024 + (ob ^ (((ob >> 9) & 1) << 5)); }
__host__ __device__ __forceinline__ void stage_rc(int b, int& R, int& C) { const int st = b / 1024, sb = b % 1024, swz = sb ^ (((sb >> 9) & 1) << 5); R = (st >> 1) * 16 + swz / 64; C = (st & 1) * 32 + (swz % 64) / 2; }
__host__ __device__ __forceinline__ int perm32(int rho) { const int n = rho >> 4, i = rho & 15; return 8 * (i >> 2) + 4 * n + (i & 3); }

struct Unit { int pm, pn; };
struct Gemm { const bf16_t* A; const bf16_t* Bt; int M, N, K; };

struct StaticOrder {
    int nM, nN, nwg, G, c;
    __host__ __device__ void init(int M, int N, int G_, int c_) { nM = M / BM; nN = N / BM; nwg = nM * nN; G = G_; c = c_; }
    __host__ __device__ bool next(int i, Unit& u) const {
        const long L = (long)i * G + c; if (L >= nwg) return false;
        int wgid = (int)L; { const int q = nwg / NXCD, r = nwg % NXCD, xcd = wgid % NXCD, off = wgid / NXCD; wgid = (xcd < r ? xcd * (q + 1) : r * (q + 1) + (xcd - r) * q) + off; }
        const int nig = WGM * nN, gid = wgid / nig, fm = gid * WGM, gsz = (nM - fm) < WGM ? (nM - fm) : WGM;
        u.pm = fm + ((wgid % nig) % gsz); u.pn = (wgid % nig) / gsz; return true;
    }
    __device__ __forceinline__ void a_ready(const Unit&) const {}
    __device__ __forceinline__ void done(const Unit&) const {}
};


__device__ __forceinline__ unsigned cvt_pk_bf16(float lo, float hi) { unsigned r; asm volatile("v_cvt_pk_bf16_f32 %0, %1, %2" : "=v"(r) : "v"(lo), "v"(hi)); return r; }
typedef float f32x2 __attribute__((ext_vector_type(2)));

template <int ACT  > struct EpiBf16 {
    static constexpr bool PERM = true, AFTER_DRAIN = false;
    bf16_t* O; int ldc;
    __device__ __forceinline__ void operator()(const f32x4 (&acc)[2][2][4][2], const Unit& u, int wr, int wc, int fr, int fq) const {
        const int row0 = u.pm * BM + wr * 64 + fr, col0 = u.pn * BM + wc * 32 + 8 * fq;
#pragma unroll
        for (int ai = 0; ai < 2; ++ai)
#pragma unroll
            for (int m = 0; m < 4; ++m) { bf16_t* rowp = O + (size_t)(row0 + ai * HALF + m * 16) * ldc + col0;
#pragma unroll
                for (int bj = 0; bj < 2; ++bj) { f32x4 v0 = acc[ai][bj][m][0], v1 = acc[ai][bj][m][1];
                    if (ACT == 1) {
#pragma unroll
                        for (int j = 0; j < 4; ++j) { const float a = v0[j] > 0.f ? v0[j] : 0.f, b = v1[j] > 0.f ? v1[j] : 0.f; v0[j] = a * a; v1[j] = b * b; } }
                    u32x4 w; w.x = cvt_pk_bf16(v0[0], v0[1]); w.y = cvt_pk_bf16(v0[2], v0[3]); w.z = cvt_pk_bf16(v1[0], v1[1]); w.w = cvt_pk_bf16(v1[2], v1[3]);
                    *(u32x4*)(rowp + bj * HALF) = w; } }
    }
};
struct EpiProj {
    static constexpr bool PERM = true, AFTER_DRAIN = false;
    bf16_t* O; const float* CS; float* out; int layer;
    __device__ __forceinline__ void operator()(const f32x4 (&acc)[2][2][4][2], const Unit& u, int wr, int wc, int fr, int fq) const {
        const int pn = u.pn, row0 = u.pm * BM + wr * 64 + fr, col0 = pn * BM + wc * 32 + 8 * fq;
        const int kind = pn < 4 ? 0 : pn < 6 ? 1 : pn < 14 ? 2 : pn < 18 ? 0 : 3;
        const float rsc = (pn >= 10 && pn < 14) ? 0.08838834764831845f : 1.0f;
#pragma unroll
        for (int ai = 0; ai < 2; ++ai)
#pragma unroll
            for (int m = 0; m < 4; ++m) { const int row = row0 + ai * HALF + m * 16; bf16_t* rowp = O + (size_t)row * 5632 + col0;
                f32x4 cs0 = (f32x4){1.f, 0.f, 1.f, 0.f}, cs1 = cs0;
                if (kind == 2) { const int pos = row < 8192 ? row : 4096 + ((row - 8192) & 15); const float* cp = CS + ((size_t)pos * 64 + wc * 16 + fq * 4) * 2; cs0 = *(const f32x4*)cp; cs1 = *(const f32x4*)(cp + 4); }
#pragma unroll
                for (int bj = 0; bj < 2; ++bj) { f32x4 v0 = acc[ai][bj][m][0], v1 = acc[ai][bj][m][1];
                    if (kind == 2) {
                        f32x4 r0, r1;
                        r0[0] = (v0[0] * cs0[0] - v0[1] * cs0[1]) * rsc; r0[1] = (v0[1] * cs0[0] + v0[0] * cs0[1]) * rsc;
                        r0[2] = (v0[2] * cs0[2] - v0[3] * cs0[3]) * rsc; r0[3] = (v0[3] * cs0[2] + v0[2] * cs0[3]) * rsc;
                        r1[0] = (v1[0] * cs1[0] - v1[1] * cs1[1]) * rsc; r1[1] = (v1[1] * cs1[0] + v1[0] * cs1[1]) * rsc;
                        r1[2] = (v1[2] * cs1[2] - v1[3] * cs1[3]) * rsc; r1[3] = (v1[3] * cs1[2] + v1[2] * cs1[3]) * rsc;
                        v0 = r0; v1 = r1;
                    } else if (kind == 3) {
#pragma unroll
                        for (int j = 0; j < 4; ++j) { v0[j] = v0[j] / (1.f + __expf(-v0[j])); v1[j] = v1[j] / (1.f + __expf(-v1[j])); }
                    } else if (kind == 1) {
                        if (row >= 8064) { const int which = pn - 4;
                            float* dst = row < 8192 ? out + (which ? OFF_NVP : OFF_NKP) + (size_t)layer * 32768 + (size_t)(row - 8064) * 256
                                                    : out + (which ? OFF_NVS : OFF_NKS) + (size_t)layer * 131072 + (size_t)(row - 8192) * 256;
                            dst += bj * HALF + wc * 32 + 8 * fq; *(f32x4*)dst = v0; *(f32x4*)(dst + 4) = v1; }
                    }
                    u32x4 w; w.x = cvt_pk_bf16(v0[0], v0[1]); w.y = cvt_pk_bf16(v0[2], v0[3]); w.z = cvt_pk_bf16(v1[0], v1[1]); w.w = cvt_pk_bf16(v1[2], v1[3]);
                    *(u32x4*)(rowp + bj * HALF) = w; } }
    }
};
struct EpiRes {
    static constexpr bool PERM = false, AFTER_DRAIN = false;
    float* H;
    __device__ __forceinline__ void operator()(const f32x4 (&acc)[2][2][4][2], const Unit& u, int wr, int wc, int fr, int fq) const {
        const int row0 = u.pm * BM + wr * 64 + fr, col0 = u.pn * BM + wc * 32 + 4 * fq;
#pragma unroll
        for (int ai = 0; ai < 2; ++ai)
#pragma unroll
            for (int m = 0; m < 4; ++m) { float* rowp = H + (size_t)(row0 + ai * HALF + m * 16) * 2048 + col0;
#pragma unroll
                for (int bj = 0; bj < 2; ++bj)
#pragma unroll
                    for (int n = 0; n < 2; ++n) { f32x4* p = (f32x4*)(rowp + bj * HALF + n * 16); const f32x4 o = *p; *p = o + acc[ai][bj][m][n]; }
                asm volatile("" ::: "memory"); }
    }
};
struct EpiF32 {
    static constexpr bool PERM = false, AFTER_DRAIN = false;
    float* C;
    __device__ __forceinline__ void operator()(const f32x4 (&acc)[2][2][4][2], const Unit& u, int wr, int wc, int fr, int fq) const {
        const int row0 = u.pm * BM + wr * 64 + fr, col0 = u.pn * BM + wc * 32 + 4 * fq;
#pragma unroll
        for (int ai = 0; ai < 2; ++ai)
#pragma unroll
            for (int m = 0; m < 4; ++m) { float* rowp = C + (size_t)(row0 + ai * HALF + m * 16) * 2048 + col0;
#pragma unroll
                for (int bj = 0; bj < 2; ++bj)
#pragma unroll
                    for (int n = 0; n < 2; ++n) *(f32x4*)(rowp + bj * HALF + n * 16) = acc[ai][bj][m][n]; }
    }
};
struct EpiGate {
    static constexpr bool PERM = false, AFTER_DRAIN = false;
    float* H; const float* PL;
    __device__ __forceinline__ void operator()(const f32x4 (&acc)[2][2][4][2], const Unit& u, int wr, int wc, int fr, int fq) const {
        const int row0 = u.pm * BM + wr * 64 + fr, col0 = u.pn * BM + wc * 32 + 4 * fq;
#pragma unroll
        for (int ai = 0; ai < 2; ++ai)
#pragma unroll
            for (int m = 0; m < 4; ++m) { const size_t off = (size_t)(row0 + ai * HALF + m * 16) * 2048 + col0;
#pragma unroll
                for (int bj = 0; bj < 2; ++bj)
#pragma unroll
                    for (int n = 0; n < 2; ++n) { f32x4* p = (f32x4*)(H + off + bj * HALF + n * 16); const f32x4 pl = *(const f32x4*)(PL + off + bj * HALF + n * 16); const f32x4 a = acc[ai][bj][m][n]; f32x4 g;
#pragma unroll
                        for (int j = 0; j < 4; ++j) g[j] = 1.f / (1.f + __expf(-a[j]));
                        const f32x4 o = *p; *p = o + g * pl; }
                asm volatile("" ::: "memory"); }
    }
};


template <class Epi, class Sched, bool ALIGN_EPI = false, bool SP2 = false>
__device__ __forceinline__ void gemm_phase(PG8_LAS unsigned char* lds, const Gemm g, const Sched& S, const Epi& E, const int wave_s) {
    int tid_ = wave_s * 64 + (int)__builtin_amdgcn_mbcnt_hi(~0u, __builtin_amdgcn_mbcnt_lo(~0u, 0u)); asm volatile("" : "+v"(tid_));
    const int tid = tid_, wid = wave_s, lane = tid & 63, wr = wid >> 2, wc = wid & 3, fr = lane & 15, fq = lane >> 4;
    const int K = g.K, nt = K / BK;
    unsigned voffA[2], voffB[2];
#pragma unroll
    for (int i = 0; i < 2; ++i) { int R, C; stage_rc(tid * 16 + i * 8192, R, C); const int Rb = Epi::PERM ? ((R & ~31) + perm32(R & 31)) : R;
        voffA[i] = (unsigned)(R * K + C) * 2u; voffB[i] = (unsigned)(Rb * K + C) * 2u; }
    const size_t kstep = (size_t)(BK * 2);
    const size_t hstep = (size_t)HALF * K * 2;
    const size_t tstep = 2 * hstep;
    const unsigned ldsw = (unsigned)wid * 1024u;
    const int aoff = lds_byte(wr * 64 + fr, fq * 8), boff = lds_byte(wc * 32 + fr, fq * 8);
#define PG8_SA(b, h) (((b) * 2 + (h)) * HTB)
#define PG8_SB(b, h) ((4 + (b) * 2 + (h)) * HTB)
#define PG8_STAGE(bufoff, gbase, voff) do { _Pragma("unroll") for (int _i = 0; _i < 2; ++_i) \
        __builtin_amdgcn_global_load_lds((const unsigned*)((const char*)(gbase) + (voff)[_i]), (PG8_LAS unsigned*)(lds + (bufoff) + ldsw + _i * 8192), 16, 0, 0); } while (0)
#define PG8_LDA(dst, b, h) do { _Pragma("unroll") for (int m = 0; m < 4; ++m) _Pragma("unroll") for (int k = 0; k < 2; ++k) dst[m][k] = *(const PG8_LAS bf16x8*)(lds + PG8_SA(b, h) + aoff + m * 2048 + k * 1024); } while (0)
#define PG8_LDB(dst, b, h) do { _Pragma("unroll") for (int n = 0; n < 2; ++n) _Pragma("unroll") for (int k = 0; k < 2; ++k) dst[n][k] = *(const PG8_LAS bf16x8*)(lds + PG8_SB(b, h) + boff + n * 2048 + k * 1024); } while (0)
#define PG8_MMA(ai, bj, At, Bt) do { __builtin_amdgcn_s_setprio(1); _Pragma("unroll") for (int m = 0; m < 4; ++m) _Pragma("unroll") for (int n = 0; n < 2; ++n) _Pragma("unroll") for (int k = 0; k < 2; ++k) \
        acc[ai][bj][m][n] = __builtin_amdgcn_mfma_f32_16x16x32_bf16(Bt[n][k], At[m][k], acc[ai][bj][m][n], 0, 0, 0); __builtin_amdgcn_s_setprio(0); } while (0)
#define PG8_WAIT_V(n) asm volatile("s_waitcnt vmcnt(" #n ")" ::: "memory")
#define PG8_WAIT_L(n) asm volatile("s_waitcnt lgkmcnt(" #n ")" ::: "memory")
#define PG8_BAR __builtin_amdgcn_s_barrier()
#define PG8_SCHED __builtin_amdgcn_sched_barrier(0)
    Unit cur, nxt; int ui = 0;
    if (!S.next(0, cur)) return;
    f32x4 acc[2][2][4][2];
#pragma unroll
    for (int a = 0; a < 2; ++a)
#pragma unroll
        for (int b = 0; b < 2; ++b)
#pragma unroll
            for (int m = 0; m < 4; ++m)
#pragma unroll
                for (int n = 0; n < 2; ++n) acc[a][b][m][n] = (f32x4){0.f, 0.f, 0.f, 0.f};
    bf16x8 At[4][2], B0[2][2], B1[2][2];
    const char* cA = (const char*)g.A + (size_t)cur.pm * tstep; const char* cB = (const char*)g.Bt + (size_t)cur.pn * tstep;
    S.a_ready(cur);
    if constexpr (SP2) {
        PG8_STAGE(PG8_SB(0, 0), cB, voffB); PG8_STAGE(PG8_SB(0, 1), cB + hstep, voffB); PG8_STAGE(PG8_SA(0, 0), cA, voffA); PG8_STAGE(PG8_SA(0, 1), cA + hstep, voffA);
        if (wr == 1) PG8_BAR;
        PG8_WAIT_V(2); PG8_BAR;
        PG8_STAGE(PG8_SB(1, 0), cB + kstep, voffB); PG8_STAGE(PG8_SA(1, 0), cA + kstep, voffA); PG8_STAGE(PG8_SB(1, 1), cB + hstep + kstep, voffB);
        PG8_WAIT_V(6); PG8_BAR;
    } else {
        PG8_STAGE(PG8_SB(0, 0), cB, voffB); PG8_STAGE(PG8_SA(0, 0), cA, voffA); PG8_STAGE(PG8_SB(0, 1), cB + hstep, voffB); PG8_STAGE(PG8_SA(0, 1), cA + hstep, voffA);
        if (wr == 1) PG8_BAR;
        PG8_WAIT_V(4); PG8_BAR;
        PG8_STAGE(PG8_SB(1, 0), cB + kstep, voffB); PG8_STAGE(PG8_SA(1, 0), cA + kstep, voffA); PG8_STAGE(PG8_SB(1, 1), cB + hstep + kstep, voffB);
        PG8_WAIT_V(6); PG8_BAR;
    }
    for (;;) {
        const bool has_next = S.next(ui + 1, nxt);
        const char* nA = has_next ? (const char*)g.A + (size_t)nxt.pm * tstep : cA; const char* nB = has_next ? (const char*)g.Bt + (size_t)nxt.pn * tstep : cB;
        for (int t = 0; t < nt; t += 2) {
            const bool last = (t == nt - 2);
            const char* a1 = cA + (size_t)(t + 1) * kstep;
            const char* a2 = last ? nA : cA + (size_t)(t + 2) * kstep; const char* b2 = last ? nB : cB + (size_t)(t + 2) * kstep;
            const char* a3 = a2 + kstep; const char* b3 = b2 + kstep;
            if (last && has_next) S.a_ready(nxt);
            if constexpr (SP2) {
            PG8_LDB(B0, 0, 0); PG8_LDB(B1, 0, 1); PG8_SCHED; PG8_LDA(At, 0, 0); PG8_STAGE(PG8_SA(1, 1), a1 + hstep, voffA);
            PG8_WAIT_V(8); PG8_WAIT_L(0); PG8_BAR; PG8_MMA(0, 0, At, B0); PG8_MMA(0, 1, At, B1); PG8_BAR; PG8_SCHED;
            PG8_LDA(At, 0, 1); PG8_STAGE(PG8_SB(0, 0), b2, voffB); PG8_STAGE(PG8_SB(0, 1), b2 + hstep, voffB); PG8_STAGE(PG8_SA(0, 0), a2, voffA);
            PG8_WAIT_V(8); PG8_WAIT_L(0); PG8_BAR; PG8_MMA(1, 0, At, B0); PG8_MMA(1, 1, At, B1); PG8_BAR; PG8_SCHED;
            PG8_LDB(B0, 1, 0); PG8_LDB(B1, 1, 1); PG8_SCHED; PG8_LDA(At, 1, 0); PG8_STAGE(PG8_SA(0, 1), a2 + hstep, voffA);
            PG8_WAIT_V(8); PG8_WAIT_L(0); PG8_BAR; PG8_MMA(0, 0, At, B0); PG8_MMA(0, 1, At, B1); PG8_BAR; PG8_SCHED;
            PG8_LDA(At, 1, 1); PG8_STAGE(PG8_SB(1, 0), b3, voffB); PG8_STAGE(PG8_SB(1, 1), b3 + hstep, voffB); PG8_STAGE(PG8_SA(1, 0), a3, voffA);
            PG8_WAIT_V(8); PG8_WAIT_L(0); PG8_BAR; PG8_MMA(1, 0, At, B0); PG8_MMA(1, 1, At, B1); PG8_BAR; PG8_SCHED;
            } else {
            PG8_LDB(B0, 0, 0); PG8_SCHED; PG8_LDA(At, 0, 0); PG8_STAGE(PG8_SA(1, 1), a1 + hstep, voffA);
            PG8_WAIT_L(8); PG8_BAR; PG8_WAIT_L(0); PG8_MMA(0, 0, At, B0); PG8_BAR; PG8_SCHED;
            PG8_LDB(B1, 0, 1); PG8_STAGE(PG8_SB(0, 0), b2, voffB);
            PG8_BAR; PG8_WAIT_L(0); PG8_MMA(0, 1, At, B1); PG8_BAR;
            PG8_LDA(At, 0, 1); PG8_STAGE(PG8_SA(0, 0), a2, voffA);
            PG8_BAR; PG8_WAIT_L(0); PG8_MMA(1, 0, At, B0); PG8_BAR; PG8_SCHED;
            PG8_STAGE(PG8_SB(0, 1), b2 + hstep, voffB);
            PG8_WAIT_V(6); PG8_BAR; PG8_MMA(1, 1, At, B1); PG8_BAR;
            PG8_LDB(B0, 1, 0); PG8_SCHED; PG8_LDA(At, 1, 0); PG8_STAGE(PG8_SA(0, 1), a2 + hstep, voffA);
            PG8_WAIT_L(8); PG8_BAR; PG8_WAIT_L(0); PG8_MMA(0, 0, At, B0); PG8_BAR; PG8_SCHED;
            PG8_LDB(B1, 1, 1); PG8_STAGE(PG8_SB(1, 0), b3, voffB);
            PG8_BAR; PG8_WAIT_L(0); PG8_MMA(0, 1, At, B1); PG8_BAR;
            PG8_LDA(At, 1, 1); PG8_STAGE(PG8_SA(1, 0), a3, voffA);
            PG8_BAR; PG8_WAIT_L(0); PG8_MMA(1, 0, At, B0); PG8_BAR; PG8_SCHED;
            PG8_STAGE(PG8_SB(1, 1), b3 + hstep, voffB);
            PG8_WAIT_V(6); PG8_BAR; PG8_MMA(1, 1, At, B1); PG8_BAR;
            }
        }
        if constexpr (ALIGN_EPI) { if (wr == 0) PG8_BAR; }
        if constexpr (!Epi::AFTER_DRAIN) { E(acc, cur, wr, wc, fr, fq); S.done(cur); }
        if (!has_next) break;
#pragma unroll
        for (int a = 0; a < 2; ++a)
#pragma unroll
            for (int b = 0; b < 2; ++b)
#pragma unroll
                for (int m = 0; m < 4; ++m)
#pragma unroll
                    for (int n = 0; n < 2; ++n) acc[a][b][m][n] = (f32x4){0.f, 0.f, 0.f, 0.f};
        cur = nxt; cA = nA; cB = nB; ++ui;
        if constexpr (ALIGN_EPI) { if (wr == 1) PG8_BAR; }
    }
    PG8_WAIT_V(0);
    if constexpr (!ALIGN_EPI) { if (wr == 0) PG8_BAR; }
    PG8_BAR;
    if constexpr (Epi::AFTER_DRAIN) { E.fused(acc, cur, wr, wc, fr, fq, lds, wid, lane); S.done(cur); }
#undef PG8_SA
#undef PG8_SB
#undef PG8_STAGE
#undef PG8_LDA
#undef PG8_LDB
#undef PG8_MMA
#undef PG8_WAIT_V
#undef PG8_WAIT_L
#undef PG8_BAR
#undef PG8_SCHED
}
}

#define LAS __attribute__((address_space(3)))
typedef unsigned short bf16;
typedef float f32x4 __attribute__((ext_vector_type(4)));
typedef unsigned v4u __attribute__((ext_vector_type(4)));
#define LDS_WAIT() asm volatile("s_waitcnt lgkmcnt(0)" ::: "memory")
__device__ __forceinline__ int opaque_tid(int wave_s) { int t = wave_s * 64 + (int)__builtin_amdgcn_mbcnt_hi(~0u, __builtin_amdgcn_mbcnt_lo(~0u, 0u)); asm volatile("" : "+v"(t)); return t; }
__device__ __forceinline__ unsigned f2bf(float f) { unsigned u = __builtin_bit_cast(unsigned, f); return (u + 0x7fffu + ((u >> 16) & 1u)) >> 16; }
__device__ __forceinline__ unsigned pk2(float lo, float hi) { return f2bf(lo) | (f2bf(hi) << 16); }
__device__ __forceinline__ float bf2f(unsigned x) { return __uint_as_float(x << 16); }
__device__ __forceinline__ float wave_sum(float v) {
#pragma unroll
    for (int o = 1; o < 64; o <<= 1) v += __shfl_xor(v, o);
    return v;
}
__device__ __forceinline__ int t5_bucket(int rel) {
    const int ret = rel > 0 ? 16 : 0; const int n = rel < 0 ? -rel : rel;
    if (n < 8) return ret + n;
    const int v = (n * n) >> 6; int lg = 31 - __clz(v); int large = 8 + lg; if (large > 15) large = 15;
    return ret + large;
}
__device__ __forceinline__ int in_src_col(int n) {
    if (n < 1536 || n >= 3584) return n;
    const int base = n < 2560 ? 1536 : 2560, rel = n - base, s = rel & 127;
    return base + (rel & ~127) + (s >> 1) + 64 * (s & 1);
}
__device__ __forceinline__ void conv_item(const float* W, int K, int N, bf16* WT, LAS float* scr, int item, int lane, bool perm_in) {
    const int nblk = N / 32, kb = item / nblk, nb = item % nblk, k0 = 64 * kb, n0 = 32 * nb;
    int nsrc = n0 + (lane & 31); if (perm_in) nsrc = in_src_col(nsrc);
#pragma unroll 8
    for (int i = 0; i < 32; ++i) { const int kk = 2 * i + (lane >> 5); scr[kk * 33 + (lane & 31)] = W[(size_t)(k0 + kk) * N + nsrc]; }
    LDS_WAIT(); asm volatile("" ::: "memory");
    const int c = lane & 7;
#pragma unroll
    for (int j = 0; j < 4; ++j) { const int n = (lane >> 3) + 8 * j; const LAS float* s = scr + (8 * c) * 33 + n;
        v4u o; o.x = pk2(s[0 * 33], s[1 * 33]); o.y = pk2(s[2 * 33], s[3 * 33]); o.z = pk2(s[4 * 33], s[5 * 33]); o.w = pk2(s[6 * 33], s[7 * 33]);
        *(v4u*)(WT + (size_t)(n0 + n) * K + k0 + 8 * c) = o; }
    LDS_WAIT(); asm volatile("" ::: "memory");
}
__device__ __forceinline__ void rms_row_bf16(const float* xrow, const float* g, bf16* yrow, float* hcopy, int lane) {
    const f32x4* xr = (const f32x4*)xrow + lane; f32x4 v[8]; float s = 0.f;
#pragma unroll
    for (int j = 0; j < 8; ++j) { v[j] = xr[64 * j]; s += (v[j].x * v[j].x + v[j].y * v[j].y) + (v[j].z * v[j].z + v[j].w * v[j].w); }
    const float rs = rsqrtf(wave_sum(s) * (1.f / D) + EPS);
    if (hcopy) { f32x4* hr = (f32x4*)hcopy + lane;
#pragma unroll
        for (int j = 0; j < 8; ++j) hr[64 * j] = v[j]; }
    const f32x4* gr = (const f32x4*)g + lane; uint2* yr = (uint2*)yrow + lane;
#pragma unroll
    for (int j = 0; j < 8; ++j) { const f32x4 gg = gr[64 * j]; uint2 w; w.x = pk2(v[j].x * rs * gg.x, v[j].y * rs * gg.y); w.y = pk2(v[j].z * rs * gg.z, v[j].w * rs * gg.w); yr[64 * j] = w; }
}
__device__ __forceinline__ void ph_rmsnorm_bf16(const Params& P, const float* g, int wave_s) {
    const float* H = (const float*)(P.ws + WS_H); bf16* UB = (bf16*)(P.ws + WS_UB);
    const int tid = opaque_tid(wave_s); const int lane = tid & 63, gw = blockIdx.x * 8 + (tid >> 6), ngw = gridDim.x * 8;
    for (int r = gw; r < M; r += ngw) rms_row_bf16(H + (size_t)r * D, g, UB + (size_t)r * D, nullptr, lane);
}
__device__ __forceinline__ void ph_final_norm(const Params& P, int wave_s) {
    const float* H = (const float*)(P.ws + WS_H);
    const int tid = opaque_tid(wave_s); const int lane = tid & 63, gw = blockIdx.x * 8 + (tid >> 6), ngw = gridDim.x * 8;
    for (int r = gw; r < M; r += ngw) {
        const f32x4* xr = (const f32x4*)(H + (size_t)r * D) + lane; f32x4 v[8]; float s = 0.f;
#pragma unroll
        for (int j = 0; j < 8; ++j) { v[j] = xr[64 * j]; s += (v[j].x * v[j].x + v[j].y * v[j].y) + (v[j].z * v[j].z + v[j].w * v[j].w); }
        const float rs = rsqrtf(wave_sum(s) * (1.f / D) + EPS);
        f32x4* yr = (f32x4*)(P.out + OFF_Y + (size_t)r * D) + lane; const f32x4* gr = (const f32x4*)P.norm_final + lane;
#pragma unroll
        for (int j = 0; j < 8; ++j) yr[64 * j] = v[j] * rs * gr[64 * j];
    }
}
__device__ __forceinline__ void ph_prologue(const Params& P, LAS unsigned char* lds, int wave_s) {
    const int tid = opaque_tid(wave_s), lane = tid & 63, wave = tid >> 6;
    const int gw = blockIdx.x * 8 + wave, ngw = gridDim.x * 8;
    LAS float* scr = (LAS float*)(lds + wave * 16384);
    constexpr int I_IN = 32 * 176, I_OUT = 32 * 64, I_UP = 32 * 256, I_DOWN = 128 * 64, I_GATE = 32 * 64, I_PLE = 4 * 64, I_L = I_IN + I_OUT + I_UP + I_DOWN + I_GATE + I_PLE;
    for (int it = gw; it < 2 * I_L; it += ngw) {
        const int l = it / I_L; int r = it % I_L; unsigned char* wl = P.ws + WS_W + (size_t)l * WL_STRIDE;
        if (r < I_IN) { conv_item(P.w_in + (size_t)l * D * INW, D, INW, (bf16*)(wl + WL_IN), scr, r, lane, true); continue; } r -= I_IN;
        if (r < I_OUT) { conv_item(P.w_out + (size_t)l * D * D, D, D, (bf16*)(wl + WL_OUT), scr, r, lane, false); continue; } r -= I_OUT;
        if (r < I_UP) { conv_item(P.w_up + (size_t)l * D * FFW, D, FFW, (bf16*)(wl + WL_UP), scr, r, lane, false); continue; } r -= I_UP;
        if (r < I_DOWN) { conv_item(P.w_down + (size_t)l * FFW * D, FFW, D, (bf16*)(wl + WL_DOWN), scr, r, lane, false); continue; } r -= I_DOWN;
        if (r < I_GATE) { conv_item(P.w_gate + (size_t)l * D * D, D, D, (bf16*)(wl + WL_GATE), scr, r, lane, false); continue; } r -= I_GATE;
        conv_item(P.w_ple + (size_t)l * PLE * D, PLE, D, (bf16*)(wl + WL_PLE), scr, r, lane, false);
    }
    float* H = (float*)(P.ws + WS_H); bf16* UB = (bf16*)(P.ws + WS_UB);
    for (int r = gw; r < M; r += ngw) {
        const float* xrow = r < SEQ ? P.x_prompt + (size_t)r * D : P.x_sample + (size_t)(r - SEQ) * D;
        rms_row_bf16(xrow, P.norm_mix, UB + (size_t)r * D, H + (size_t)r * D, lane);
    }
    const size_t gt = (size_t)blockIdx.x * 512 + tid, gs = (size_t)gridDim.x * 512;
    bf16* PBB = (bf16*)(P.ws + WS_PBB);
    for (size_t i = gt; i < (size_t)2 * M * PLE / 4; i += gs) {
        const size_t e = i * 4; const int l = (int)(e / ((size_t)M * PLE)); const size_t r = e % ((size_t)M * PLE); f32x4 v;
        if (r < (size_t)SEQ * PLE) v = *(const f32x4*)(P.p_prompt + (size_t)l * SEQ * PLE + r); else v = *(const f32x4*)(P.p_sample + (size_t)l * NSAMP * PLE + (r - (size_t)SEQ * PLE));
        uint2 w; w.x = pk2(v.x, v.y); w.y = pk2(v.z, v.w); *(uint2*)(PBB + e) = w;
    }
    float* CS = (float*)(P.ws + WS_CS);
    for (size_t i = gt; i < (size_t)SEQ * 64; i += gs) {
        const int pos = (int)(i >> 6), d = (int)(i & 63);
        const double inv = pow(10000.0, -(double)d / 64.0); const double ang = (double)pos * inv;
        CS[2 * i] = (float)cos(ang); CS[2 * i + 1] = (float)sin(ang);
    }
}

__device__ __forceinline__ void ld16_bf16(const bf16* p, f32x4 (&o)[4]) {
    const v4u a = *(const v4u*)p, b = *(const v4u*)(p + 8);
    o[0] = (f32x4){bf2f(a.x & 0xffffu), bf2f(a.x >> 16), bf2f(a.y & 0xffffu), bf2f(a.y >> 16)}; o[1] = (f32x4){bf2f(a.z & 0xffffu), bf2f(a.z >> 16), bf2f(a.w & 0xffffu), bf2f(a.w >> 16)};
    o[2] = (f32x4){bf2f(b.x & 0xffffu), bf2f(b.x >> 16), bf2f(b.y & 0xffffu), bf2f(b.y >> 16)}; o[3] = (f32x4){bf2f(b.z & 0xffffu), bf2f(b.z >> 16), bf2f(b.w & 0xffffu), bf2f(b.w >> 16)};
}
__device__ __forceinline__ void ld16_f32(const float* p, f32x4 (&o)[4]) {
#pragma unroll
    for (int j = 0; j < 4; ++j) o[j] = *(const f32x4*)(p + 4 * j);
}
__device__ __forceinline__ void ph_attn_naive(const Params& P, int l, int wave_s) {
    const bf16* PROJ = (const bf16*)(P.ws + WS_BIG); bf16* MIXB = (bf16*)(P.ws + WS_MIXB);
    const int nP = SEQ * 16 * 4, nS = NSAMP * 16 * 4;
    const int tid = opaque_tid(wave_s);
    for (int it = nP + blockIdx.x * 512 + tid; it < nP + nS; it += gridDim.x * 512) {
        const bool sample = it >= nP; int row, hq, c = 0, b = 0, qi = 0; const int part = it & 3;
        if (!sample) { const int q = (it >> 2) & 63; hq = (it >> 8) & 15; c = it >> 12; row = c * 64 + q; }
        else { const int j = it - nP; qi = (j >> 2) & 15; hq = (j >> 6) & 15; b = j >> 10; row = SEQ + b * 16 + qi; }
        const int kh = hq >> 2; const float sink = P.attn_sink[l * 16 + hq];
        f32x4 q[4], acc[4];
        ld16_bf16(PROJ + (size_t)row * INW + hq * 64 + part * 16, q);
#pragma unroll
        for (int d4 = 0; d4 < 4; ++d4) acc[d4] = (f32x4){0.f, 0.f, 0.f, 0.f};
        float m = sink, ls = 1.f;
        const int nk = sample ? 144 : 192;
#pragma unroll 1
        for (int s = 0; s < nk; ++s) {
            f32x4 kk[4], vv[4]; int rel;
            if (!sample) { const int kpos = c * 64 - 128 + s; if (kpos < 0) continue; rel = kpos - row;
                const bf16* kp = PROJ + (size_t)kpos * INW + 1024 + kh * 64 + part * 16; ld16_bf16(kp, kk); ld16_bf16(kp + 256, vv); }
            else { rel = s - 128 - qi;
                if (s < 128) { const size_t o = ((((size_t)l * DEC_B + b) * 128 + s) * 4 + kh) * 64 + part * 16; ld16_f32(P.cache_k + o, kk); ld16_f32(P.cache_v + o, vv); }
                else { const bf16* kp = PROJ + (size_t)(SEQ + b * 16 + (s - 128)) * INW + 1024 + kh * 64 + part * 16; ld16_bf16(kp, kk); ld16_bf16(kp + 256, vv); } }
            float dot = 0.f;
#pragma unroll
            for (int d4 = 0; d4 < 4; ++d4) dot += (q[d4].x * kk[d4].x + q[d4].y * kk[d4].y) + (q[d4].z * kk[d4].z + q[d4].w * kk[d4].w);
            dot += __shfl_xor(dot, 1); dot += __shfl_xor(dot, 2);
            const float sc = dot * 0.125f + P.rel_bias[t5_bucket(rel) * 16 + hq];
            const float mn = fmaxf(m, sc), corr = __expf(m - mn), p = __expf(sc - mn);
            ls = ls * corr + p; m = mn;
#pragma unroll
            for (int d4 = 0; d4 < 4; ++d4) acc[d4] = acc[d4] * corr + vv[d4] * p;
        }
        const float inv = 1.f / ls;
        v4u w0, w1;
        w0.x = pk2(acc[0].x * inv, acc[0].y * inv); w0.y = pk2(acc[0].z * inv, acc[0].w * inv); w0.z = pk2(acc[1].x * inv, acc[1].y * inv); w0.w = pk2(acc[1].z * inv, acc[1].w * inv);
        w1.x = pk2(acc[2].x * inv, acc[2].y * inv); w1.y = pk2(acc[2].z * inv, acc[2].w * inv); w1.z = pk2(acc[3].x * inv, acc[3].y * inv); w1.w = pk2(acc[3].z * inv, acc[3].w * inv);
        bf16* op = MIXB + (size_t)row * D + hq * 64 + part * 16; *(v4u*)op = w0; *(v4u*)(op + 8) = w1;
    }
}
typedef short bf16x8 __attribute__((ext_vector_type(8)));
__device__ __forceinline__ f32x4 mma_blk(const LAS bf16* F, int ldf, const LAS bf16* S, int lds_, int kd, f32x4 acc, int fr, int fq) {
    for (int k = 0; k < kd; k += 32) {
        const bf16x8 a = *(const LAS bf16x8*)(F + fr * ldf + k + fq * 8);
        const bf16x8 b = *(const LAS bf16x8*)(S + fr * lds_ + k + fq * 8);
        acc = __builtin_amdgcn_mfma_f32_16x16x32_bf16(a, b, acc, 0, 0, 0);
    }
    return acc;
}
__device__ __forceinline__ float grp16_max(float v) { v = fmaxf(v, __shfl_xor(v, 1)); v = fmaxf(v, __shfl_xor(v, 2)); v = fmaxf(v, __shfl_xor(v, 4)); v = fmaxf(v, __shfl_xor(v, 8)); return v; }
__device__ __forceinline__ float grp16_sum(float v) { v += __shfl_xor(v, 1); v += __shfl_xor(v, 2); v += __shfl_xor(v, 4); v += __shfl_xor(v, 8); return v; }

__device__ __forceinline__ void attn_prompt_unit(const Params& P, int l, int c, int kh, LAS unsigned char* lds, int tid) {
    const bf16* PROJ = (const bf16*)(P.ws + WS_BIG); bf16* MIXB = (bf16*)(P.ws + WS_MIXB);
    LAS bf16* Ks = (LAS bf16*)lds;
    LAS bf16* Vt = (LAS bf16*)(lds + 27648);
    LAS bf16* Pw = (LAS bf16*)(lds + 53248);
    LAS float* LUT = (LAS float*)(lds + 104448);
    const int lane = tid & 63, w = tid >> 6, fr = lane & 15, fq = lane >> 4;
    const v4u zero4 = (v4u){0u, 0u, 0u, 0u};
#pragma unroll
    for (int i = 0; i < 3; ++i) { const int idx = tid + i * 512, key = idx >> 3, ch = idx & 7; const int kpos = c * 64 - 128 + key;
        v4u v = zero4; if (kpos >= 0) v = *(const v4u*)(PROJ + (size_t)kpos * INW + 1024 + kh * 64 + ch * 8);
        *(LAS v4u*)(Ks + key * 72 + ch * 8) = v; }
#pragma unroll
    for (int grp = 0; grp < 3; ++grp) { const int key = grp * 64 + lane, kpos = c * 64 - 128 + key;
        v4u v = zero4; if (kpos >= 0) v = *(const v4u*)(PROJ + (size_t)kpos * INW + 1280 + kh * 64 + w * 8);
        LAS bf16* d = Vt + (w * 8) * 200 + key;
        d[0 * 200] = (bf16)(v.x & 0xffffu); d[1 * 200] = (bf16)(v.x >> 16); d[2 * 200] = (bf16)(v.y & 0xffffu); d[3 * 200] = (bf16)(v.y >> 16);
        d[4 * 200] = (bf16)(v.z & 0xffffu); d[5 * 200] = (bf16)(v.z >> 16); d[6 * 200] = (bf16)(v.w & 0xffffu); d[7 * 200] = (bf16)(v.w >> 16); }
    for (int t = tid; t < 1020; t += 512) { const int g = t / 255, idx = t % 255; LUT[g * 256 + idx] = P.rel_bias[t5_bucket(idx - 191) * 16 + kh * 4 + g]; }
    __syncthreads();
#pragma unroll 1
    for (int pass = 0; pass < 2; ++pass) {
        const int r0 = (2 * w + pass) * 16, g = r0 >> 6, hq = kh * 4 + g; const float sink = P.attn_sink[l * 16 + hq];
        bf16x8 qf[2];
        { const int q = (r0 + fr) & 63; const bf16* qp = PROJ + (size_t)(c * 64 + q) * INW + hq * 64 + fq * 8; qf[0] = *(const bf16x8*)qp; qf[1] = *(const bf16x8*)(qp + 32); }
        f32x4 acc[12];
#pragma unroll
        for (int kb = 0; kb < 12; ++kb) { acc[kb] = (f32x4){0.f, 0.f, 0.f, 0.f};
#pragma unroll
            for (int ks = 0; ks < 2; ++ks) { const bf16x8 b = *(const LAS bf16x8*)(Ks + (kb * 16 + fr) * 72 + ks * 32 + fq * 8); acc[kb] = __builtin_amdgcn_mfma_f32_16x16x32_bf16(qf[ks], b, acc[kb], 0, 0, 0); } }
        LAS bf16* pw = Pw + w * (16 * 200);
#pragma unroll
        for (int reg = 0; reg < 4; ++reg) {
            const int q = (r0 + fq * 4 + reg) & 63; float mx = -INFINITY;
#pragma unroll
            for (int kb = 0; kb < 12; ++kb) { const int key = kb * 16 + fr; float s = acc[kb][reg] * 0.125f + LUT[g * 256 + key - q + 63]; if (c * 64 - 128 + key < 0) s = -INFINITY; acc[kb][reg] = s; mx = fmaxf(mx, s); }
            const float m = fmaxf(grp16_max(mx), sink); float sum = 0.f;
#pragma unroll
            for (int kb = 0; kb < 12; ++kb) { const float p = __expf(acc[kb][reg] - m); acc[kb][reg] = p; sum += p; }
            const float inv = 1.f / (grp16_sum(sum) + __expf(sink - m));
#pragma unroll
            for (int kb = 0; kb < 12; ++kb) pw[(fq * 4 + reg) * 200 + kb * 16 + fr] = (bf16)f2bf(acc[kb][reg] * inv);
        }
        LDS_WAIT(); asm volatile("" ::: "memory");
        f32x4 o[4];
#pragma unroll
        for (int db = 0; db < 4; ++db) o[db] = mma_blk(Vt + db * 16 * 200, 200, pw, 200, 192, (f32x4){0.f, 0.f, 0.f, 0.f}, fr, fq);
        { const int q = (r0 + fr) & 63; bf16* op = MIXB + (size_t)(c * 64 + q) * D + hq * 64 + fq * 4;
#pragma unroll
            for (int db = 0; db < 4; ++db) { uint2 wv; wv.x = pk2(o[db][0], o[db][1]); wv.y = pk2(o[db][2], o[db][3]); *(uint2*)(op + db * 16) = wv; } }
        LDS_WAIT(); asm volatile("" ::: "memory");
    }
    __syncthreads();
}

__device__ __forceinline__ void ret_upd_unit(const Params& P, int c, int h, LAS unsigned char* lds, int tid) {
    const bf16* PROJ = (const bf16*)(P.ws + WS_BIG); bf16* UPDt = (bf16*)(P.ws + WS_UPD);
    LAS bf16* Kt = (LAS bf16*)lds;
    LAS bf16* Vzt = (LAS bf16*)(lds + 18432);
    const int lane = tid & 63, w = tid >> 6, fr = lane & 15, fq = lane >> 4;
    const float lg2 = log2f(1.f - exp2f(-5.f - (float)h));
    const float zeta = exp2f((float)(63 - lane) * lg2);
    const bf16* rowp = PROJ + (size_t)(c * 64 + lane) * INW + h * 128;
#pragma unroll
    for (int i = 0; i < 2; ++i) { const int cc = w + 8 * i;
        const v4u kv = *(const v4u*)(rowp + 2560 + cc * 8), vv = *(const v4u*)(rowp + 3584 + cc * 8);
        LAS bf16* dk = Kt + (cc * 8) * 72 + lane; LAS bf16* dv = Vzt + (cc * 8) * 72 + lane;
        dk[0 * 72] = (bf16)(kv.x & 0xffffu); dk[1 * 72] = (bf16)(kv.x >> 16); dk[2 * 72] = (bf16)(kv.y & 0xffffu); dk[3 * 72] = (bf16)(kv.y >> 16);
        dk[4 * 72] = (bf16)(kv.z & 0xffffu); dk[5 * 72] = (bf16)(kv.z >> 16); dk[6 * 72] = (bf16)(kv.w & 0xffffu); dk[7 * 72] = (bf16)(kv.w >> 16);
        dv[0 * 72] = (bf16)f2bf(bf2f(vv.x & 0xffffu) * zeta); dv[1 * 72] = (bf16)f2bf(bf2f(vv.x >> 16) * zeta); dv[2 * 72] = (bf16)f2bf(bf2f(vv.y & 0xffffu) * zeta); dv[3 * 72] = (bf16)f2bf(bf2f(vv.y >> 16) * zeta);
        dv[4 * 72] = (bf16)f2bf(bf2f(vv.z & 0xffffu) * zeta); dv[5 * 72] = (bf16)f2bf(bf2f(vv.z >> 16) * zeta); dv[6 * 72] = (bf16)f2bf(bf2f(vv.w & 0xffffu) * zeta); dv[7 * 72] = (bf16)f2bf(bf2f(vv.w >> 16) * zeta); }
    __syncthreads();
    bf16* up = UPDt + ((size_t)(c * 8 + h) * 128) * 128;
#pragma unroll
    for (int eb = 0; eb < 8; ++eb) {
        const f32x4 a = mma_blk(Kt + (w * 16) * 72, 72, Vzt + (eb * 16) * 72, 72, 64, (f32x4){0.f, 0.f, 0.f, 0.f}, fr, fq);
        uint2 wv; wv.x = pk2(a[0], a[1]); wv.y = pk2(a[2], a[3]);
        *(uint2*)(up + (size_t)(eb * 16 + fr) * 128 + w * 16 + fq * 4) = wv;
    }
    __syncthreads();
}
__device__ __forceinline__ void ph_ret_scan(const Params& P, int l, int wave_s) {
    const bf16* UPDt = (const bf16*)(P.ws + WS_UPD); bf16* SprevT = (bf16*)(P.ws + WS_UB);
    const int tid = opaque_tid(wave_s);
    for (int pr = blockIdx.x * 512 + tid; pr < 8 * 128 * 64; pr += gridDim.x * 512) {
        const int h = pr >> 13, e = (pr >> 6) & 127, s2 = (pr & 63) * 2;
        const float g64 = exp2f(64.f * log2f(1.f - exp2f(-5.f - (float)h)));
        const size_t off = ((size_t)h * 128 + e) * 128 + s2; const size_t cstride = (size_t)8 * 128 * 128;
        float s0 = 0.f, s1 = 0.f;
#pragma unroll 1
        for (int c0 = 0; c0 < 128; c0 += 8) {
            unsigned u[8];
#pragma unroll
            for (int k = 0; k < 8; ++k) u[k] = *(const unsigned*)(UPDt + off + (size_t)(c0 + k) * cstride);
#pragma unroll
            for (int k = 0; k < 8; ++k) { *(unsigned*)(SprevT + off + (size_t)(c0 + k) * cstride) = pk2(s0, s1); s0 = g64 * s0 + bf2f(u[k] & 0xffffu); s1 = g64 * s1 + bf2f(u[k] >> 16); }
        }
        float* so = P.out + OFF_NSP + ((size_t)l * 8 + h) * 16384;
        { const int od0 = (s2 >> 1), od1 = (s2 >> 1) + 64; so[od0 * 128 + e] = s0; so[od1 * 128 + e] = s1; }
    }
}
__device__ __forceinline__ void ret_out_unit(const Params& P, int l, int c, int h, LAS unsigned char* lds, int tid) {
    const bf16* PROJ = (const bf16*)(P.ws + WS_BIG); const bf16* SprevT = (const bf16*)(P.ws + WS_UB); bf16* MIXB = (bf16*)(P.ws + WS_MIXB);
    LAS bf16* Qs = (LAS bf16*)lds;
    LAS bf16* Ks = (LAS bf16*)(lds + 17408);
    LAS bf16* Vt = (LAS bf16*)(lds + 34816);
    LAS bf16* St = (LAS bf16*)(lds + 53248);
    LAS bf16* Pm = (LAS bf16*)(lds + 88064);
    LAS float* Of = (LAS float*)(lds + 97280);
    const int lane = tid & 63, w = tid >> 6, fr = lane & 15, fq = lane >> 4;
    const float lg2 = log2f(1.f - exp2f(-5.f - (float)h));
#pragma unroll
    for (int i = 0; i < 2; ++i) { const int idx = tid + i * 512, r = idx >> 4, ch = idx & 15; const bf16* rp = PROJ + (size_t)(c * 64 + r) * INW + h * 128 + ch * 8;
        *(LAS v4u*)(Qs + r * 136 + ch * 8) = *(const v4u*)(rp + 1536); *(LAS v4u*)(Ks + r * 136 + ch * 8) = *(const v4u*)(rp + 2560); }
    { const bf16* sp = SprevT + ((size_t)(c * 8 + h) * 128) * 128;
#pragma unroll
      for (int i = 0; i < 4; ++i) { const int idx = tid + i * 512, e = idx >> 4, ch = idx & 15; *(LAS v4u*)(St + e * 136 + ch * 8) = *(const v4u*)(sp + (size_t)e * 128 + ch * 8); } }
    { const bf16* rowp = PROJ + (size_t)(c * 64 + lane) * INW + 3584 + h * 128;
#pragma unroll
      for (int i = 0; i < 2; ++i) { const int cc = w + 8 * i; const v4u vv = *(const v4u*)(rowp + cc * 8); LAS bf16* dv = Vt + (cc * 8) * 72 + lane;
        dv[0 * 72] = (bf16)(vv.x & 0xffffu); dv[1 * 72] = (bf16)(vv.x >> 16); dv[2 * 72] = (bf16)(vv.y & 0xffffu); dv[3 * 72] = (bf16)(vv.y >> 16);
        dv[4 * 72] = (bf16)(vv.z & 0xffffu); dv[5 * 72] = (bf16)(vv.z >> 16); dv[6 * 72] = (bf16)(vv.w & 0xffffu); dv[7 * 72] = (bf16)(vv.w >> 16); } }
    __syncthreads();
    const int ib = w >> 1;
#pragma unroll
    for (int jj = 0; jj < 2; ++jj) { const int jb = (w & 1) * 2 + jj;
        const f32x4 a = mma_blk(Qs + (ib * 16) * 136, 136, Ks + (jb * 16) * 136, 136, 128, (f32x4){0.f, 0.f, 0.f, 0.f}, fr, fq);
#pragma unroll
        for (int reg = 0; reg < 4; ++reg) { const int i = ib * 16 + fq * 4 + reg, j = jb * 16 + fr; const float v = i >= j ? a[reg] * exp2f((float)(i - j) * lg2) : 0.f; Pm[i * 72 + j] = (bf16)f2bf(v); } }
    __syncthreads();
#pragma unroll
    for (int ee = 0; ee < 4; ++ee) { const int eb = (w & 1) * 4 + ee;
        const f32x4 pv = mma_blk(Pm + (ib * 16) * 72, 72, Vt + (eb * 16) * 72, 72, 64, (f32x4){0.f, 0.f, 0.f, 0.f}, fr, fq);
        const f32x4 x = mma_blk(Qs + (ib * 16) * 136, 136, St + (eb * 16) * 136, 136, 128, (f32x4){0.f, 0.f, 0.f, 0.f}, fr, fq);
#pragma unroll
        for (int reg = 0; reg < 4; ++reg) { const int i = ib * 16 + fq * 4 + reg; Of[i * 132 + eb * 16 + fr] = pv[reg] + exp2f((float)(i + 1) * lg2) * x[reg]; } }
    __syncthreads();
    { const int i = tid >> 3, e0 = (tid & 7) * 16; f32x4 v[4]; float ss = 0.f;
#pragma unroll
      for (int k = 0; k < 4; ++k) { v[k] = *(const LAS f32x4*)(Of + i * 132 + e0 + 4 * k); ss += (v[k].x * v[k].x + v[k].y * v[k].y) + (v[k].z * v[k].z + v[k].w * v[k].w); }
      ss += __shfl_xor(ss, 1); ss += __shfl_xor(ss, 2); ss += __shfl_xor(ss, 4);
      const float rs = rsqrtf(ss * (1.f / 128.f) + EPS);
      f32x4 gt[4]; ld16_bf16(PROJ + (size_t)(c * 64 + i) * INW + 4608 + h * 128 + e0, gt);
      const float* gn = P.ret_gain + l * 1024 + h * 128 + e0; v4u w0, w1; f32x4 r[4];
#pragma unroll
      for (int k = 0; k < 4; ++k) { const f32x4 gg = *(const f32x4*)(gn + 4 * k); r[k] = gt[k] * (v[k] * rs * gg); }
      w0.x = pk2(r[0].x, r[0].y); w0.y = pk2(r[0].z, r[0].w); w0.z = pk2(r[1].x, r[1].y); w0.w = pk2(r[1].z, r[1].w);
      w1.x = pk2(r[2].x, r[2].y); w1.y = pk2(r[2].z, r[2].w); w1.z = pk2(r[3].x, r[3].y); w1.w = pk2(r[3].z, r[3].w);
      bf16* op = MIXB + (size_t)(c * 64 + i) * D + 1024 + h * 128 + e0; *(v4u*)op = w0; *(v4u*)(op + 8) = w1; }
    __syncthreads();
}
__device__ __forceinline__ void ret_sample_item(const Params& P, int l, int b, int h, LAS unsigned char* lds, int tid) {
    const bf16* PROJ = (const bf16*)(P.ws + WS_BIG); bf16* MIXB = (bf16*)(P.ws + WS_MIXB);
    LAS float* sq = (LAS float*)lds; LAS float* sk = sq + 16 * 128; LAS float* so = sk + 16 * 128;
    const int row0 = SEQ + b * 16;
    const float gamma = 1.f - exp2f(-5.f - (float)h);
    float S[64]; const int e = tid & 127, half = (tid >> 7) & 1;
    const float* s0 = P.state_ret + (((size_t)l * DEC_B + b) * 8 + h) * 16384;
#pragma unroll
    for (int d = 0; d < 64; ++d) { const int s = half * 64 + d, od = (s >> 1) + 64 * (s & 1); S[d] = s0[od * 128 + e]; }
    for (int i = tid; i < 4096; i += 512) { const int tt = i >> 8, dd = i & 255, which = dd >> 7, d = dd & 127;
        const float v = bf2f(PROJ[(size_t)(row0 + tt) * INW + (which ? 2560 : 1536) + h * 128 + d]); (which ? sk : sq)[tt * 128 + d] = v; }
    __syncthreads();
    if (tid < 256) {
#pragma unroll 1
        for (int tt = 0; tt < 16; ++tt) {
            const float v = bf2f(PROJ[(size_t)(row0 + tt) * INW + 3584 + h * 128 + e]); float o = 0.f;
#pragma unroll
            for (int d = 0; d < 64; ++d) { S[d] = gamma * S[d] + sk[tt * 128 + half * 64 + d] * v; o += sq[tt * 128 + half * 64 + d] * S[d]; }
            so[(tt * 2 + half) * 128 + e] = o;
        }
        float* sp = P.out + OFF_NSS + (((size_t)l * DEC_B + b) * 8 + h) * 16384;
#pragma unroll
        for (int d = 0; d < 64; ++d) { const int s = half * 64 + d, od = (s >> 1) + 64 * (s & 1); sp[od * 128 + e] = S[d]; }
    }
    __syncthreads();
    { const int tt = tid >> 5, e0 = (tid & 31) * 4; float o[4]; float ss = 0.f;
#pragma unroll
      for (int k = 0; k < 4; ++k) { o[k] = so[(tt * 2) * 128 + e0 + k] + so[(tt * 2 + 1) * 128 + e0 + k]; ss += o[k] * o[k]; }
      ss += __shfl_xor(ss, 1); ss += __shfl_xor(ss, 2); ss += __shfl_xor(ss, 4); ss += __shfl_xor(ss, 8); ss += __shfl_xor(ss, 16);
      const float rs = rsqrtf(ss * (1.f / 128.f) + EPS);
      const bf16* gp = PROJ + (size_t)(row0 + tt) * INW + 4608 + h * 128 + e0; const float* gn = P.ret_gain + l * 1024 + h * 128 + e0;
      uint2 wv; wv.x = pk2(bf2f(gp[0]) * (o[0] * rs * gn[0]), bf2f(gp[1]) * (o[1] * rs * gn[1])); wv.y = pk2(bf2f(gp[2]) * (o[2] * rs * gn[2]), bf2f(gp[3]) * (o[3] * rs * gn[3]));
      *(uint2*)(MIXB + (size_t)(row0 + tt) * D + 1024 + h * 128 + e0) = wv; }
    __syncthreads();
}
__device__ __forceinline__ void ph_mix1(const Params& P, int l, LAS unsigned char* lds, int wave_s) {
    const int tid = opaque_tid(wave_s);
    const int G = gridDim.x, bx = blockIdx.x;
    for (int u = bx; u < 512; u += G) attn_prompt_unit(P, l, u >> 2, u & 3, lds, tid);
    for (int u = bx; u < 1024; u += G) ret_upd_unit(P, u >> 3, u & 7, lds, tid);
    for (int u = bx; u < 256; u += G) ret_sample_item(P, l, u >> 3, u & 7, lds, tid);
}
__device__ __forceinline__ void ph_mix3(const Params& P, int l, LAS unsigned char* lds, int wave_s) {
    const int tid = opaque_tid(wave_s);
    for (int u = blockIdx.x; u < 1024; u += gridDim.x) ret_out_unit(P, l, u >> 3, u & 7, lds, tid);
}
#define GEMM_PHASE(EPI, ...) pg8::gemm_phase<EPI, pg8::StaticOrder, true, true>(lds, g, S, E, wave_s)
template <int l> __device__ __forceinline__ void layer_body(const Params& P, LAS unsigned char* lds, cg::grid_group& grid, int wave_s) {
    const int G = gridDim.x, bx = blockIdx.x;
    float* H = (float*)(P.ws + WS_H); bf16* UB = (bf16*)(P.ws + WS_UB); bf16* MIXB = (bf16*)(P.ws + WS_MIXB);
    bf16* PROJB = (bf16*)(P.ws + WS_BIG); bf16* FFB = (bf16*)(P.ws + WS_BIG); float* PL = (float*)(P.ws + WS_BIG); bf16* PBB = (bf16*)(P.ws + WS_PBB);
    const float* CS = (const float*)(P.ws + WS_CS);
    const unsigned char* wl = P.ws + WS_W + (size_t)l * WL_STRIDE;
    if (l > 0) { ph_rmsnorm_bf16(P, P.norm_mix + l * D, wave_s); grid.sync(); }
#ifndef NO_P1
    { pg8::Gemm g{UB, (const bf16*)(wl + WL_IN), M, INW, D}; pg8::StaticOrder S; S.init(M, INW, G, bx); pg8::EpiProj E{PROJB, CS, P.out, l}; GEMM_PHASE(pg8::EpiProj); }
#endif
    grid.sync();
    ph_attn_naive(P, l, wave_s);
    ph_mix1(P, l, lds, wave_s); grid.sync();
    ph_ret_scan(P, l, wave_s); grid.sync();
    ph_mix3(P, l, lds, wave_s); grid.sync();
#ifndef NO_P4
    { pg8::Gemm g{MIXB, (const bf16*)(wl + WL_OUT), M, D, D}; pg8::StaticOrder S; S.init(M, D, G, bx); pg8::EpiRes E{H}; GEMM_PHASE(pg8::EpiRes); }
#endif
    grid.sync();
    ph_rmsnorm_bf16(P, P.norm_mlp + l * D, wave_s); grid.sync();
#ifndef NO_P5
    { pg8::Gemm g{UB, (const bf16*)(wl + WL_UP), M, FFW, D}; pg8::StaticOrder S; S.init(M, FFW, G, bx); pg8::EpiBf16<1> E{FFB, FFW}; GEMM_PHASE(pg8::EpiBf16<1>); }
#endif
    grid.sync();
#ifndef NO_P6
    { pg8::Gemm g{FFB, (const bf16*)(wl + WL_DOWN), M, D, FFW}; pg8::StaticOrder S; S.init(M, D, G, bx); pg8::EpiRes E{H}; GEMM_PHASE(pg8::EpiRes); }
#endif
    grid.sync();
    ph_rmsnorm_bf16(P, P.norm_ple + l * D, wave_s); grid.sync();
#ifndef NO_P7
    { pg8::Gemm g{PBB + (size_t)l * M * PLE, (const bf16*)(wl + WL_PLE), M, D, PLE}; pg8::StaticOrder S; S.init(M, D, G, bx); pg8::EpiF32 E{PL}; GEMM_PHASE(pg8::EpiF32); }
#endif
#ifndef NO_P8
    { pg8::Gemm g{UB, (const bf16*)(wl + WL_GATE), M, D, D}; pg8::StaticOrder S; S.init(M, D, G, bx); pg8::EpiGate E{H, PL}; GEMM_PHASE(pg8::EpiGate); }
#endif
    grid.sync();
}
__global__ void __launch_bounds__(512, 2) k_mega(Params P) {
    extern __shared__ __attribute__((aligned(16))) unsigned char lds_raw[];
    LAS unsigned char* lds = (LAS unsigned char*)lds_raw;
    cg::grid_group grid = cg::this_grid();
    const int wave_s = __builtin_amdgcn_readfirstlane((int)(threadIdx.x >> 6));
#ifndef NO_P0
    ph_prologue(P, lds, wave_s);
#endif
    grid.sync();
    layer_body<0>(P, lds, grid, wave_s);
    layer_body<1>(P, lds, grid, wave_s);
    ph_final_norm(P, wave_s);
}

extern "C" void kernel_launch(void* const* d_in, const int* in_sizes, int n_in, void* d_out, int out_size, void* d_ws, size_t ws_size, hipStream_t stream) {
    static int grid_blocks = 0;
    if (!grid_blocks) {
        int dev = 0, cus = 0, per_cu = 0;
        (void)hipGetDevice(&dev);
        (void)hipDeviceGetAttribute(&cus, hipDeviceAttributeMultiprocessorCount, dev);
        (void)hipFuncSetAttribute((const void*)k_mega, hipFuncAttributeMaxDynamicSharedMemorySize, LDS_BYTES);
        (void)hipOccupancyMaxActiveBlocksPerMultiprocessor(&per_cu, (const void*)k_mega, 512, LDS_BYTES);
        if (per_cu != 1) fprintf(stderr, "kernel_launch: occupancy query says %d blocks per CU (expected 1)\n", per_cu);
        grid_blocks = cus;
        if (ws_size < WS_W + 2 * WL_STRIDE) fprintf(stderr, "kernel_launch: workspace too small: %zu\n", ws_size);
    }
    Params P{};
    const float** pp = (const float**)&P;
    for (int i = 0; i < 20; ++i) pp[i] = (const float*)d_in[i];
    P.out = (float*)d_out; P.ws = (unsigned char*)d_ws;
    void* args[] = {&P};
    hipError_t e = hipLaunchCooperativeKernel((const void*)k_mega, dim3(grid_blocks), dim3(512), args, LDS_BYTES, stream);
    if (e != hipSuccess) fprintf(stderr, "cooperative launch failed: %s (grid %d)\n", hipGetErrorString(e), grid_blocks);
}
```

```cpp
#include <hip/hip_runtime.h>
#include <hip/hip_cooperative_groups.h>
#include <cstdint>
#include <cstdio>
namespace cg = cooperative_groups;

constexpr int D = 2048, SEQ = 8192, NSAMP = 512, M = SEQ + NSAMP, INW = 5632, FFW = 8192, PLE = 256;
constexpr int DEC_B = 32, DEC_L = 16;
constexpr float EPS = 1e-6f;
constexpr size_t OFF_Y = 0;
constexpr size_t OFF_NKP = (size_t)M * D;
constexpr size_t OFF_NVP = OFF_NKP + 2 * 128 * 256;
constexpr size_t OFF_NSP = OFF_NVP + 2 * 128 * 256;
constexpr size_t OFF_NKS = OFF_NSP + 2 * 8 * 16384;
constexpr size_t OFF_NVS = OFF_NKS + 2 * 512 * 256;
constexpr size_t OFF_NSS = OFF_NVS + 2 * 512 * 256;
constexpr size_t MiB = 1u << 20;
constexpr size_t WS_H = 0;
constexpr size_t WS_UB = 68 * MiB;
constexpr size_t WS_MIXB = 102 * MiB;
constexpr size_t WS_BIG = 136 * MiB;
constexpr size_t WS_UPD = WS_BIG + 94 * MiB;
constexpr size_t WS_PBB = 272 * MiB;
constexpr size_t WS_CS = 281 * MiB;
constexpr size_t WS_CTL = 285 * MiB;
constexpr size_t CTL_BAR = 0, CTL_SS = 128 * 1024, CTL_ZERO_BYTES = 512 * 1024;
constexpr size_t WS_W = 286 * MiB;
constexpr size_t WS_HB2 = 492 * MiB;
constexpr size_t WL_IN = 0, WL_OUT = 22 * MiB, WL_UP = 30 * MiB, WL_DOWN = 62 * MiB, WL_GATE = 94 * MiB, WL_PLE = 102 * MiB, WL_STRIDE = 103 * MiB;
constexpr int LDS_MISC_OFF = 131072 + 1024;
constexpr int LDS_BYTES = 147456;

struct Params {
    const float *x_prompt, *x_sample, *cache_k, *cache_v, *state_ret, *p_prompt, *p_sample, *rel_bias, *norm_mix, *w_in, *attn_sink,
        *ret_gain, *w_out, *norm_mlp, *w_up, *w_down, *norm_ple, *w_gate, *w_ple, *norm_final;
    float* out; unsigned char* ws;
};


namespace pg8 {
#define PG8_LAS __attribute__((address_space(3)))
typedef unsigned short bf16_t;
typedef short bf16x8 __attribute__((ext_vector_type(8)));
typedef float f32x4 __attribute__((ext_vector_type(4)));
typedef unsigned u32x4 __attribute__((ext_vector_type(4)));
constexpr int BM = 256, BK = 64, HALF = 128, HTB = HALF * BK * 2  , STAGE_BYTES = 8 * HTB, NXCD = 8, WGM = 8;

__host__ __device__ __forceinline__ int lds_byte(int r, int c) { const int st = (r >> 4) * 2 + (c >> 5), rr = r & 15, cc = c & 31, ob = rr * 64 + cc * 2; return st * 1024 + (ob ^ (((ob >> 9) & 1) << 5)); }
__host__ __device__ __forceinline__ void stage_rc(int b, int& R, int& C) { const int st = b / 1024, sb = b % 1024, swz = sb ^ (((sb >> 9) & 1) << 5); R = (st >> 1) * 16 + swz / 64; C = (st & 1) * 32 + (swz % 64) / 2; }
__host__ __device__ __forceinline__ int perm32(int rho) { const int n = rho >> 4, i = rho & 15; return 8 * (i >> 2) + 4 * n + (i & 3); }

struct Unit { int pm, pn; };
struct Gemm { const bf16_t* A; const bf16_t* Bt; int M, N, K; };

struct StaticOrder {
    int nM, nN, nwg, G, c;
    __host__ __device__ void init(int M, int N, int G_, int c_) { nM = M / BM; nN = N / BM; nwg = nM * nN; G = G_; c = c_; }
    __host__ __device__ bool next(int i, Unit& u) const {
        const long L = (long)i * G + c; if (L >= nwg) return false;
        int wgid = (int)L; { const int q = nwg / NXCD, r = nwg % NXCD, xcd = wgid % NXCD, off = wgid / NXCD; wgid = (xcd < r ? xcd * (q + 1) : r * (q + 1) + (xcd - r) * q) + off; }
        const int nig = WGM * nN, gid = wgid / nig, fm = gid * WGM, gsz = (nM - fm) < WGM ? (nM - fm) : WGM;
        u.pm = fm + ((wgid % nig) % gsz); u.pn = (wgid % nig) / gsz; return true;
    }
    __device__ __forceinline__ void a_ready(const Unit&) const {}
    __device__ __forceinline__ void done(const Unit&) const {}
};


__device__ __forceinline__ unsigned cvt_pk_bf16(float lo, float hi) { unsigned r; asm volatile("v_cvt_pk_bf16_f32 %0, %1, %2" : "=v"(r) : "v"(lo), "v"(hi)); return r; }
typedef float f32x2 __attribute__((ext_vector_type(2)));

__device__ __forceinline__ float rstd_of(const float* ss, int row) { return rsqrtf(__hip_atomic_load(ss + row, __ATOMIC_RELAXED, __HIP_MEMORY_SCOPE_AGENT) * (1.f / 2048.f) + 1e-6f); }
template <int ACT  > struct EpiBf16 {
    static constexpr bool PERM = true, AFTER_DRAIN = false;
    bf16_t* O; int ldc; const float* ss;
    __device__ __forceinline__ void operator()(const f32x4 (&acc)[2][2][4][2], const Unit& u, int wr, int wc, int fr, int fq) const {
        const int row0 = u.pm * BM + wr * 64 + fr, col0 = u.pn * BM + wc * 32 + 8 * fq;
#pragma unroll
        for (int ai = 0; ai < 2; ++ai)
#pragma unroll
            for (int m = 0; m < 4; ++m) { const int row = row0 + ai * HALF + m * 16; bf16_t* rowp = O + (size_t)row * ldc + col0;
                const float rs = rstd_of(ss, row);
#pragma unroll
                for (int bj = 0; bj < 2; ++bj) { f32x4 v0 = acc[ai][bj][m][0] * rs, v1 = acc[ai][bj][m][1] * rs;
                    if (ACT == 1) {
#pragma unroll
                        for (int j = 0; j < 4; ++j) { const float a = v0[j] > 0.f ? v0[j] : 0.f, b = v1[j] > 0.f ? v1[j] : 0.f; v0[j] = a * a; v1[j] = b * b; } }
                    u32x4 w; w.x = cvt_pk_bf16(v0[0], v0[1]); w.y = cvt_pk_bf16(v0[2], v0[3]); w.z = cvt_pk_bf16(v1[0], v1[1]); w.w = cvt_pk_bf16(v1[2], v1[3]);
                    *(u32x4*)(rowp + bj * HALF) = w; } }
    }
};
struct EpiProj {
    static constexpr bool PERM = true, AFTER_DRAIN = false;
    bf16_t* O; const float* CS; float* out; int layer; const float* ss;
    __device__ __forceinline__ void operator()(const f32x4 (&acc)[2][2][4][2], const Unit& u, int wr, int wc, int fr, int fq) const {
        const int pn = u.pn, row0 = u.pm * BM + wr * 64 + fr, col0 = pn * BM + wc * 32 + 8 * fq;
        const int kind = pn < 4 ? 0 : pn < 6 ? 1 : pn < 14 ? 2 : pn < 18 ? 0 : 3;
        const float rsc = (pn >= 10 && pn < 14) ? 0.08838834764831845f : 1.0f;
#pragma unroll
        for (int ai = 0; ai < 2; ++ai)
#pragma unroll
            for (int m = 0; m < 4; ++m) { const int row = row0 + ai * HALF + m * 16; bf16_t* rowp = O + (size_t)row * 5632 + col0;
                const float rs = rstd_of(ss, row);
                f32x4 cs0 = (f32x4){1.f, 0.f, 1.f, 0.f}, cs1 = cs0;
                if (kind == 2) { const int pos = row < 8192 ? row : 4096 + ((row - 8192) & 15); const float* cp = CS + ((size_t)pos * 64 + wc * 16 + fq * 4) * 2; cs0 = *(const f32x4*)cp; cs1 = *(const f32x4*)(cp + 4); }
#pragma unroll
                for (int bj = 0; bj < 2; ++bj) { f32x4 v0 = acc[ai][bj][m][0] * rs, v1 = acc[ai][bj][m][1] * rs;
                    if (kind == 2) {
                        f32x4 r0, r1;
                        r0[0] = (v0[0] * cs0[0] - v0[1] * cs0[1]) * rsc; r0[1] = (v0[1] * cs0[0] + v0[0] * cs0[1]) * rsc;
                        r0[2] = (v0[2] * cs0[2] - v0[3] * cs0[3]) * rsc; r0[3] = (v0[3] * cs0[2] + v0[2] * cs0[3]) * rsc;
                        r1[0] = (v1[0] * cs1[0] - v1[1] * cs1[1]) * rsc; r1[1] = (v1[1] * cs1[0] + v1[0] * cs1[1]) * rsc;
                        r1[2] = (v1[2] * cs1[2] - v1[3] * cs1[3]) * rsc; r1[3] = (v1[3] * cs1[2] + v1[2] * cs1[3]) * rsc;
                        v0 = r0; v1 = r1;
                    } else if (kind == 3) {
#pragma unroll
                        for (int j = 0; j < 4; ++j) { v0[j] = v0[j] / (1.f + __expf(-v0[j])); v1[j] = v1[j] / (1.f + __expf(-v1[j])); }
                    } else if (kind == 1) {
                        if (row >= 8064) { const int which = pn - 4;
                            float* dst = row < 8192 ? out + (which ? OFF_NVP : OFF_NKP) + (size_t)layer * 32768 + (size_t)(row - 8064) * 256
                                                    : out + (which ? OFF_NVS : OFF_NKS) + (size_t)layer * 131072 + (size_t)(row - 8192) * 256;
                            dst += bj * HALF + wc * 32 + 8 * fq; *(f32x4*)dst = v0; *(f32x4*)(dst + 4) = v1; }
                    }
                    u32x4 w; w.x = cvt_pk_bf16(v0[0], v0[1]); w.y = cvt_pk_bf16(v0[2], v0[3]); w.z = cvt_pk_bf16(v1[0], v1[1]); w.w = cvt_pk_bf16(v1[2], v1[3]);
                    *(u32x4*)(rowp + bj * HALF) = w; } }
    }
};
struct EpiRes {
    static constexpr bool PERM = false, AFTER_DRAIN = false;
    float* H; bf16_t* HB; float* ssq;
    __device__ __forceinline__ void operator()(const f32x4 (&acc)[2][2][4][2], const Unit& u, int wr, int wc, int fr, int fq) const {
        const int row0 = u.pm * BM + wr * 64 + fr, col0 = u.pn * BM + wc * 32 + 4 * fq;
#pragma unroll
        for (int ai = 0; ai < 2; ++ai)
#pragma unroll
            for (int m = 0; m < 4; ++m) { const int row = row0 + ai * HALF + m * 16; float* rowp = H + (size_t)row * 2048 + col0; bf16_t* bp = HB + (size_t)row * 2048 + col0; float q = 0.f;
#pragma unroll
                for (int bj = 0; bj < 2; ++bj)
#pragma unroll
                    for (int n = 0; n < 2; ++n) { f32x4* p = (f32x4*)(rowp + bj * HALF + n * 16); const f32x4 o = *p + acc[ai][bj][m][n]; *p = o;
                        q += (o[0] * o[0] + o[1] * o[1]) + (o[2] * o[2] + o[3] * o[3]);
                        uint2 w; w.x = cvt_pk_bf16(o[0], o[1]); w.y = cvt_pk_bf16(o[2], o[3]); *(uint2*)(bp + bj * HALF + n * 16) = w; }
                q += __shfl_xor(q, 16); q += __shfl_xor(q, 32);
                if (fq == 0) unsafeAtomicAdd(ssq + row, q);
                asm volatile("" ::: "memory"); }
    }
};
struct EpiF32 {
    static constexpr bool PERM = false, AFTER_DRAIN = false;
    float* C;
    __device__ __forceinline__ void operator()(const f32x4 (&acc)[2][2][4][2], const Unit& u, int wr, int wc, int fr, int fq) const {
        const int row0 = u.pm * BM + wr * 64 + fr, col0 = u.pn * BM + wc * 32 + 4 * fq;
#pragma unroll
        for (int ai = 0; ai < 2; ++ai)
#pragma unroll
            for (int m = 0; m < 4; ++m) { float* rowp = C + (size_t)(row0 + ai * HALF + m * 16) * 2048 + col0;
#pragma unroll
                for (int bj = 0; bj < 2; ++bj)
#pragma unroll
                    for (int n = 0; n < 2; ++n) *(f32x4*)(rowp + bj * HALF + n * 16) = acc[ai][bj][m][n]; }
    }
};
struct EpiGate {
    static constexpr bool PERM = false, AFTER_DRAIN = false;
    float* H; const float* PL; bf16_t* HB; const float* ss; float* ssq;
    __device__ __forceinline__ void operator()(const f32x4 (&acc)[2][2][4][2], const Unit& u, int wr, int wc, int fr, int fq) const {
        const int row0 = u.pm * BM + wr * 64 + fr, col0 = u.pn * BM + wc * 32 + 4 * fq;
#pragma unroll
        for (int ai = 0; ai < 2; ++ai)
#pragma unroll
            for (int m = 0; m < 4; ++m) { const int row = row0 + ai * HALF + m * 16; const size_t off = (size_t)row * 2048 + col0; const float rs = rstd_of(ss, row); float q = 0.f;
#pragma unroll
                for (int bj = 0; bj < 2; ++bj)
#pragma unroll
                    for (int n = 0; n < 2; ++n) { f32x4* p = (f32x4*)(H + off + bj * HALF + n * 16); const f32x4 pl = *(const f32x4*)(PL + off + bj * HALF + n * 16); const f32x4 a = acc[ai][bj][m][n] * rs; f32x4 g;
#pragma unroll
                        for (int j = 0; j < 4; ++j) g[j] = 1.f / (1.f + __expf(-a[j]));
                        const f32x4 o = *p + g * pl; *p = o;
                        q += (o[0] * o[0] + o[1] * o[1]) + (o[2] * o[2] + o[3] * o[3]);
                        uint2 w; w.x = cvt_pk_bf16(o[0], o[1]); w.y = cvt_pk_bf16(o[2], o[3]); *(uint2*)(HB + off + bj * HALF + n * 16) = w; }
                q += __shfl_xor(q, 16); q += __shfl_xor(q, 32);
                if (fq == 0) unsafeAtomicAdd(ssq + row, q);
                asm volatile("" ::: "memory"); }
    }
};


template <class Epi, class Sched, bool ALIGN_EPI = false, bool SP2 = false>
__device__ __forceinline__ void gemm_phase(PG8_LAS unsigned char* lds, const Gemm g, const Sched& S, const Epi& E, const int wave_s) {
    int tid_ = wave_s * 64 + (int)__builtin_amdgcn_mbcnt_hi(~0u, __builtin_amdgcn_mbcnt_lo(~0u, 0u)); asm volatile("" : "+v"(tid_));
    const int tid = tid_, wid = wave_s, lane = tid & 63, wr = wid >> 2, wc = wid & 3, fr = lane & 15, fq = lane >> 4;
    const int K = g.K, nt = K / BK;
    unsigned voffA[2], voffB[2];
#pragma unroll
    for (int i = 0; i < 2; ++i) { int R, C; stage_rc(tid * 16 + i * 8192, R, C); const int Rb = Epi::PERM ? ((R & ~31) + perm32(R & 31)) : R;
        voffA[i] = (unsigned)(R * K + C) * 2u; voffB[i] = (unsigned)(Rb * K + C) * 2u; }
    const size_t kstep = (size_t)(BK * 2);
    const size_t hstep = (size_t)HALF * K * 2;
    const size_t tstep = 2 * hstep;
    const unsigned ldsw = (unsigned)wid * 1024u;
    const int aoff = lds_byte(wr * 64 + fr, fq * 8), boff = lds_byte(wc * 32 + fr, fq * 8);
#define PG8_SA(b, h) (((b) * 2 + (h)) * HTB)
#define PG8_SB(b, h) ((4 + (b) * 2 + (h)) * HTB)
#define PG8_STAGE(bufoff, gbase, voff) do { _Pragma("unroll") for (int _i = 0; _i < 2; ++_i) \
        __builtin_amdgcn_global_load_lds((const unsigned*)((const char*)(gbase) + (voff)[_i]), (PG8_LAS unsigned*)(lds + (bufoff) + ldsw + _i * 8192), 16, 0, 0); } while (0)
#define PG8_LDA(dst, b, h) do { _Pragma("unroll") for (int m = 0; m < 4; ++m) _Pragma("unroll") for (int k = 0; k < 2; ++k) dst[m][k] = *(const PG8_LAS bf16x8*)(lds + PG8_SA(b, h) + aoff + m * 2048 + k * 1024); } while (0)
#define PG8_LDB(dst, b, h) do { _Pragma("unroll") for (int n = 0; n < 2; ++n) _Pragma("unroll") for (int k = 0; k < 2; ++k) dst[n][k] = *(const PG8_LAS bf16x8*)(lds + PG8_SB(b, h) + boff + n * 2048 + k * 1024); } while (0)
#define PG8_MMA(ai, bj, At, Bt) do { __builtin_amdgcn_s_setprio(1); _Pragma("unroll") for (int m = 0; m < 4; ++m) _Pragma("unroll") for (int n = 0; n < 2; ++n) _Pragma("unroll") for (int k = 0; k < 2; ++k) \
        acc[ai][bj][m][n] = __builtin_amdgcn_mfma_f32_16x16x32_bf16(Bt[n][k], At[m][k], acc[ai][bj][m][n], 0, 0, 0); __builtin_amdgcn_s_setprio(0); } while (0)
#define PG8_WAIT_V(n) asm volatile("s_waitcnt vmcnt(" #n ")" ::: "memory")
#define PG8_WAIT_L(n) asm volatile("s_waitcnt lgkmcnt(" #n ")" ::: "memory")
#define PG8_BAR __builtin_amdgcn_s_barrier()
#define PG8_SCHED __builtin_amdgcn_sched_barrier(0)
    Unit cur, nxt; int ui = 0;
    if (!S.next(0, cur)) return;
    f32x4 acc[2][2][4][2];
#pragma unroll
    for (int a = 0; a < 2; ++a)
#pragma unroll
        for (int b = 0; b < 2; ++b)
#pragma unroll
            for (int m = 0; m < 4; ++m)
#pragma unroll
                for (int n = 0; n < 2; ++n) acc[a][b][m][n] = (f32x4){0.f, 0.f, 0.f, 0.f};
    bf16x8 At[4][2], B0[2][2], B1[2][2];
    const char* cA = (const char*)g.A + (size_t)cur.pm * tstep; const char* cB = (const char*)g.Bt + (size_t)cur.pn * tstep;
    S.a_ready(cur);
    if constexpr (SP2) {
        PG8_STAGE(PG8_SB(0, 0), cB, voffB); PG8_STAGE(PG8_SB(0, 1), cB + hstep, voffB); PG8_STAGE(PG8_SA(0, 0), cA, voffA); PG8_STAGE(PG8_SA(0, 1), cA + hstep, voffA);
        if (wr == 1) PG8_BAR;
        PG8_WAIT_V(2); PG8_BAR;
        PG8_STAGE(PG8_SB(1, 0), cB + kstep, voffB); PG8_STAGE(PG8_SA(1, 0), cA + kstep, voffA); PG8_STAGE(PG8_SB(1, 1), cB + hstep + kstep, voffB);
        PG8_WAIT_V(6); PG8_BAR;
    } else {
        PG8_STAGE(PG8_SB(0, 0), cB, voffB); PG8_STAGE(PG8_SA(0, 0), cA, voffA); PG8_STAGE(PG8_SB(0, 1), cB + hstep, voffB); PG8_STAGE(PG8_SA(0, 1), cA + hstep, voffA);
        if (wr == 1) PG8_BAR;
        PG8_WAIT_V(4); PG8_BAR;
        PG8_STAGE(PG8_SB(1, 0), cB + kstep, voffB); PG8_STAGE(PG8_SA(1, 0), cA + kstep, voffA); PG8_STAGE(PG8_SB(1, 1), cB + hstep + kstep, voffB);
        PG8_WAIT_V(6); PG8_BAR;
    }
    for (;;) {
        const bool has_next = S.next(ui + 1, nxt);
        const char* nA = has_next ? (const char*)g.A + (size_t)nxt.pm * tstep : cA; const char* nB = has_next ? (const char*)g.Bt + (size_t)nxt.pn * tstep : cB;
        for (int t = 0; t < nt; t += 2) {
            const bool last = (t == nt - 2);
            const char* a1 = cA + (size_t)(t + 1) * kstep;
            const char* a2 = last ? nA : cA + (size_t)(t + 2) * kstep; const char* b2 = last ? nB : cB + (size_t)(t + 2) * kstep;
            const char* a3 = a2 + kstep; const char* b3 = b2 + kstep;
            if (last && has_next) S.a_ready(nxt);
            if constexpr (SP2) {
            PG8_LDB(B0, 0, 0); PG8_LDB(B1, 0, 1); PG8_SCHED; PG8_LDA(At, 0, 0); PG8_STAGE(PG8_SA(1, 1), a1 + hstep, voffA);
            PG8_WAIT_V(8); PG8_WAIT_L(0); PG8_BAR; PG8_MMA(0, 0, At, B0); PG8_MMA(0, 1, At, B1); PG8_BAR; PG8_SCHED;
            PG8_LDA(At, 0, 1); PG8_STAGE(PG8_SB(0, 0), b2, voffB); PG8_STAGE(PG8_SB(0, 1), b2 + hstep, voffB); PG8_STAGE(PG8_SA(0, 0), a2, voffA);
            PG8_WAIT_V(8); PG8_WAIT_L(0); PG8_BAR; PG8_MMA(1, 0, At, B0); PG8_MMA(1, 1, At, B1); PG8_BAR; PG8_SCHED;
            PG8_LDB(B0, 1, 0); PG8_LDB(B1, 1, 1); PG8_SCHED; PG8_LDA(At, 1, 0); PG8_STAGE(PG8_SA(0, 1), a2 + hstep, voffA);
            PG8_WAIT_V(8); PG8_WAIT_L(0); PG8_BAR; PG8_MMA(0, 0, At, B0); PG8_MMA(0, 1, At, B1); PG8_BAR; PG8_SCHED;
            PG8_LDA(At, 1, 1); PG8_STAGE(PG8_SB(1, 0), b3, voffB); PG8_STAGE(PG8_SB(1, 1), b3 + hstep, voffB); PG8_STAGE(PG8_SA(1, 0), a3, voffA);
            PG8_WAIT_V(8); PG8_WAIT_L(0); PG8_BAR; PG8_MMA(1, 0, At, B0); PG8_MMA(1, 1, At, B1); PG8_BAR; PG8_SCHED;
            } else {
            PG8_LDB(B0, 0, 0); PG8_SCHED; PG8_LDA(At, 0, 0); PG8_STAGE(PG8_SA(1, 1), a1 + hstep, voffA);
            PG8_WAIT_L(8); PG8_BAR; PG8_WAIT_L(0); PG8_MMA(0, 0, At, B0); PG8_BAR; PG8_SCHED;
            PG8_LDB(B1, 0, 1); PG8_STAGE(PG8_SB(0, 0), b2, voffB);
            PG8_BAR; PG8_WAIT_L(0); PG8_MMA(0, 1, At, B1); PG8_BAR;
            PG8_LDA(At, 0, 1); PG8_STAGE(PG8_SA(0, 0), a2, voffA);
            PG8_BAR; PG8_WAIT_L(0); PG8_MMA(1, 0, At, B0); PG8_BAR; PG8_SCHED;
            PG8_STAGE(PG8_SB(0, 1), b2 + hstep, voffB);
            PG8_WAIT_V(6); PG8_BAR; PG8_MMA(1, 1, At, B1); PG8_BAR;
            PG8_LDB(B0, 1, 0); PG8_SCHED; PG8_LDA(At, 1, 0); PG8_STAGE(PG8_SA(0, 1), a2 + hstep, voffA);
            PG8_WAIT_L(8); PG8_BAR; PG8_WAIT_L(0); PG8_MMA(0, 0, At, B0); PG8_BAR; PG8_SCHED;
            PG8_LDB(B1, 1, 1); PG8_STAGE(PG8_SB(1, 0), b3, voffB);
            PG8_BAR; PG8_WAIT_L(0); PG8_MMA(0, 1, At, B1); PG8_BAR;
            PG8_LDA(At, 1, 1); PG8_STAGE(PG8_SA(1, 0), a3, voffA);
            PG8_BAR; PG8_WAIT_L(0); PG8_MMA(1, 0, At, B0); PG8_BAR; PG8_SCHED;
            PG8_STAGE(PG8_SB(1, 1), b3 + hstep, voffB);
            PG8_WAIT_V(6); PG8_BAR; PG8_MMA(1, 1, At, B1); PG8_BAR;
            }
        }
        if constexpr (ALIGN_EPI) { if (wr == 0) PG8_BAR; }
        if constexpr (!Epi::AFTER_DRAIN) { E(acc, cur, wr, wc, fr, fq); S.done(cur); }
        if (!has_next) break;
#pragma unroll
        for (int a = 0; a < 2; ++a)
#pragma unroll
            for (int b = 0; b < 2; ++b)
#pragma unroll
                for (int m = 0; m < 4; ++m)
#pragma unroll
                    for (int n = 0; n < 2; ++n) acc[a][b][m][n] = (f32x4){0.f, 0.f, 0.f, 0.f};
        cur = nxt; cA = nA; cB = nB; ++ui;
        if constexpr (ALIGN_EPI) { if (wr == 1) PG8_BAR; }
    }
    PG8_WAIT_V(0);
    if constexpr (!ALIGN_EPI) { if (wr == 0) PG8_BAR; }
    PG8_BAR;
    if constexpr (Epi::AFTER_DRAIN) { E.fused(acc, cur, wr, wc, fr, fq, lds, wid, lane); S.done(cur); }
#undef PG8_SA
#undef PG8_SB
#undef PG8_STAGE
#undef PG8_LDA
#undef PG8_LDB
#undef PG8_MMA
#undef PG8_WAIT_V
#undef PG8_WAIT_L
#undef PG8_BAR
#undef PG8_SCHED
}
}

#define LAS __attribute__((address_space(3)))
typedef unsigned short bf16;
typedef float f32x4 __attribute__((ext_vector_type(4)));
typedef unsigned v4u __attribute__((ext_vector_type(4)));
#define LDS_WAIT() asm volatile("s_waitcnt lgkmcnt(0)" ::: "memory")
#define XB_TMO      128
#define XB_XCNT(j)  (256  + 64 * (j))
#define XB_XSUB(j)  (1280 + 64 * (j))
#define XB_XGEN(j)  (2304 + 64 * (j))
#define XB_TOP      3328
#define XB_TOPGEN   3392
#define XCD_BAR_WORDS 3456
#define XB_SPIN_CAP (1u << 18)

__device__ __forceinline__ unsigned xb_ld(unsigned* p)              { return __hip_atomic_load(p, __ATOMIC_RELAXED, __HIP_MEMORY_SCOPE_AGENT); }
__device__ __forceinline__ unsigned xb_add(unsigned* p, unsigned v) { return __hip_atomic_fetch_add(p, v, __ATOMIC_RELAXED, __HIP_MEMORY_SCOPE_AGENT); }
__device__ __forceinline__ unsigned xb_xcc_id() { return (unsigned)__builtin_amdgcn_s_getreg((3 << 11) | 20) & 0xFu; }
#define XB_SPIN(cond, bar) do { unsigned _sp = 0; while (cond) { __builtin_amdgcn_s_sleep(1); \
    if ((++_sp & 255u) == 0u) { if (xb_ld(&(bar)[XB_TMO])) break; if (_sp > XB_SPIN_CAP) { atomicAdd(&(bar)[XB_TMO], 1u); break; } } } } while (0)

struct XcdBarrier {
    int w;
    unsigned* bar; unsigned x;
    volatile LAS unsigned* st;
};

__device__ __forceinline__ XcdBarrier xcd_barrier_post(unsigned* bar, volatile LAS unsigned* st) {
    XcdBarrier b; b.bar = bar; b.x = xb_xcc_id(); b.st = st;
    if (threadIdx.x == 0) (void)xb_add(&bar[XB_XCNT(b.x)], 1u);
    return b;
}
__device__ __forceinline__ void xcd_barrier_complete(unsigned* bar, unsigned x, unsigned& nloc, unsigned& nx) {
    const unsigned G = gridDim.x * gridDim.y * gridDim.z;
    unsigned sum, cnt, mine, sp = 0u;
    for (;;) {
        sum = 0u; cnt = 0u; mine = 0u;
#pragma unroll
        for (unsigned j = 0; j < 16; ++j) { const unsigned c = xb_ld(&bar[XB_XCNT(j)]); sum += c; cnt += (c > 0u) ? 1u : 0u; mine = (j == x) ? c : mine; }
        if (sum == G) break;
        __builtin_amdgcn_s_sleep(1);
        if ((++sp & 255u) == 0u) { if (xb_ld(&bar[XB_TMO])) break; if (sp > XB_SPIN_CAP) { atomicAdd(&bar[XB_TMO], 1u); break; } }
    }
    nloc = mine > 0u ? mine : 1u; nx = cnt > 0u ? cnt : 1u;
}

__device__ __forceinline__ void xcd_barrier(const XcdBarrier& b) {
    asm volatile("s_waitcnt vmcnt(0)" ::: "memory");
    __syncthreads();
    if (b.w == 0 && __builtin_amdgcn_mbcnt_hi(~0u, __builtin_amdgcn_mbcnt_lo(~0u, 0u)) == 0u) {
        unsigned* bar = b.bar;
        __builtin_amdgcn_s_waitcnt(0);
        unsigned nloc = b.st[0], nx = b.st[1];
        if (nloc == 0u) { xcd_barrier_complete(bar, b.x, nloc, nx); b.st[0] = nloc; b.st[1] = nx; }
        const unsigned old = xb_add(&bar[XB_XSUB(b.x)], 1u);
        const unsigned gen = old / nloc;
        if (old + 1u == (gen + 1u) * nloc) {
            __builtin_amdgcn_fence(__ATOMIC_RELEASE, "agent");
            asm volatile("s_waitcnt vmcnt(0)" ::: "memory");
            const unsigned og = xb_add(&bar[XB_TOP], 1u);
            const unsigned tg = og / nx;
            if (og + 1u == (tg + 1u) * nx) xb_add(&bar[XB_TOPGEN], 1u);
            else XB_SPIN(xb_ld(&bar[XB_TOPGEN]) == tg, bar);
            __builtin_amdgcn_fence(__ATOMIC_ACQUIRE, "agent");
            xb_add(&bar[XB_XGEN(b.x)], 1u);
            asm volatile("s_waitcnt vmcnt(0)" ::: "memory");
        } else {
            XB_SPIN(xb_ld(&bar[XB_XGEN(b.x)]) == gen, bar);
            __builtin_amdgcn_fence(__ATOMIC_ACQUIRE, "agent");
            asm volatile("s_waitcnt vmcnt(0)" ::: "memory");
        }
    }
    __syncthreads();
}

__device__ __forceinline__ int opaque_tid(int wave_s) { int t = wave_s * 64 + (int)__builtin_amdgcn_mbcnt_hi(~0u, __builtin_amdgcn_mbcnt_lo(~0u, 0u)); asm volatile("" : "+v"(t)); return t; }
__device__ __forceinline__ unsigned f2bf(float f) { unsigned u = __builtin_bit_cast(unsigned, f); return (u + 0x7fffu + ((u >> 16) & 1u)) >> 16; }
__device__ __forceinline__ unsigned pk2(float lo, float hi) { return f2bf(lo) | (f2bf(hi) << 16); }
__device__ __forceinline__ float bf2f(unsigned x) { return __uint_as_float(x << 16); }
__device__ __forceinline__ float wave_sum(float v) {
#pragma unroll
    for (int o = 1; o < 64; o <<= 1) v += __shfl_xor(v, o);
    return v;
}
__device__ __forceinline__ int t5_bucket(int rel) {
    const int ret = rel > 0 ? 16 : 0; const int n = rel < 0 ? -rel : rel;
    if (n < 8) return ret + n;
    const int v = (n * n) >> 6; int lg = 31 - __clz(v); int large = 8 + lg; if (large > 15) large = 15;
    return ret + large;
}
__device__ __forceinline__ int in_src_col(int n) {
    if (n < 1536 || n >= 3584) return n;
    const int base = n < 2560 ? 1536 : 2560, rel = n - base, s = rel & 127;
    return base + (rel & ~127) + (s >> 1) + 64 * (s & 1);
}
__device__ __forceinline__ void conv_item(const float* W, int K, int N, bf16* WT, LAS float* scr, int item, int lane, bool perm_in, const float* gain) {
    const int nblk = N / 32, kb = item / nblk, nb = item % nblk, k0 = 64 * kb, n0 = 32 * nb;
    int nsrc = n0 + (lane & 31); if (perm_in) nsrc = in_src_col(nsrc);
#pragma unroll 8
    for (int i = 0; i < 32; ++i) { const int kk = 2 * i + (lane >> 5); float v = W[(size_t)(k0 + kk) * N + nsrc]; if (gain) v *= gain[k0 + kk]; scr[kk * 33 + (lane & 31)] = v; }
    LDS_WAIT(); asm volatile("" ::: "memory");
    const int c = lane & 7;
#pragma unroll
    for (int j = 0; j < 4; ++j) { const int n = (lane >> 3) + 8 * j; const LAS float* s = scr + (8 * c) * 33 + n;
        v4u o; o.x = pk2(s[0 * 33], s[1 * 33]); o.y = pk2(s[2 * 33], s[3 * 33]); o.z = pk2(s[4 * 33], s[5 * 33]); o.w = pk2(s[6 * 33], s[7 * 33]);
        *(v4u*)(WT + (size_t)(n0 + n) * K + k0 + 8 * c) = o; }
    LDS_WAIT(); asm volatile("" ::: "memory");
}
__device__ __forceinline__ void x_row_init(const float* xrow, bf16* yrow, float* hcopy, float* ss, int lane) {
    const f32x4* xr = (const f32x4*)xrow + lane; f32x4 v[8]; float s = 0.f;
#pragma unroll
    for (int j = 0; j < 8; ++j) { v[j] = xr[64 * j]; s += (v[j].x * v[j].x + v[j].y * v[j].y) + (v[j].z * v[j].z + v[j].w * v[j].w); }
    s = wave_sum(s);
    f32x4* hr = (f32x4*)hcopy + lane; uint2* yr = (uint2*)yrow + lane;
#pragma unroll
    for (int j = 0; j < 8; ++j) { hr[64 * j] = v[j]; uint2 w; w.x = pk2(v[j].x, v[j].y); w.y = pk2(v[j].z, v[j].w); yr[64 * j] = w; }
    if (lane == 0) *ss = s;
}
__device__ __forceinline__ void ph_final_norm(const Params& P, int wave_s) {
    const float* H = (const float*)(P.ws + WS_H); const float* ss = (const float*)(P.ws + WS_CTL + CTL_SS) + 6 * M;
    const int tid = opaque_tid(wave_s); const int lane = tid & 63, gw = blockIdx.x * 8 + (tid >> 6), ngw = gridDim.x * 8;
    for (int r = gw; r < M; r += ngw) {
        const f32x4* xr = (const f32x4*)(H + (size_t)r * D) + lane;
        const float rs = rsqrtf(__hip_atomic_load(ss + r, __ATOMIC_RELAXED, __HIP_MEMORY_SCOPE_AGENT) * (1.f / D) + EPS);
        f32x4* yr = (f32x4*)(P.out + OFF_Y + (size_t)r * D) + lane; const f32x4* gr = (const f32x4*)P.norm_final + lane;
#pragma unroll
        for (int j = 0; j < 8; ++j) yr[64 * j] = xr[64 * j] * rs * gr[64 * j];
    }
}
__device__ __forceinline__ void ph_prologue(const Params& P, LAS unsigned char* lds, int wave_s) {
    const int tid = opaque_tid(wave_s), lane = tid & 63, wave = tid >> 6;
    const int gw = blockIdx.x * 8 + wave, ngw = gridDim.x * 8;
    LAS float* scr = (LAS float*)(lds + wave * 16384);
    constexpr int I_IN = 32 * 176, I_OUT = 32 * 64, I_UP = 32 * 256, I_DOWN = 128 * 64, I_GATE = 32 * 64, I_PLE = 4 * 64, I_L = I_IN + I_OUT + I_UP + I_DOWN + I_GATE + I_PLE;
    for (int it = gw; it < 2 * I_L; it += ngw) {
        const int l = it / I_L; int r = it % I_L; unsigned char* wl = P.ws + WS_W + (size_t)l * WL_STRIDE;
        if (r < I_IN) { conv_item(P.w_in + (size_t)l * D * INW, D, INW, (bf16*)(wl + WL_IN), scr, r, lane, true, P.norm_mix + l * D); continue; } r -= I_IN;
        if (r < I_OUT) { conv_item(P.w_out + (size_t)l * D * D, D, D, (bf16*)(wl + WL_OUT), scr, r, lane, false, nullptr); continue; } r -= I_OUT;
        if (r < I_UP) { conv_item(P.w_up + (size_t)l * D * FFW, D, FFW, (bf16*)(wl + WL_UP), scr, r, lane, false, P.norm_mlp + l * D); continue; } r -= I_UP;
        if (r < I_DOWN) { conv_item(P.w_down + (size_t)l * FFW * D, FFW, D, (bf16*)(wl + WL_DOWN), scr, r, lane, false, nullptr); continue; } r -= I_DOWN;
        if (r < I_GATE) { conv_item(P.w_gate + (size_t)l * D * D, D, D, (bf16*)(wl + WL_GATE), scr, r, lane, false, P.norm_ple + l * D); continue; } r -= I_GATE;
        conv_item(P.w_ple + (size_t)l * PLE * D, PLE, D, (bf16*)(wl + WL_PLE), scr, r, lane, false, nullptr);
    }
    float* H = (float*)(P.ws + WS_H); bf16* HB2 = (bf16*)(P.ws + WS_HB2); float* ss0 = (float*)(P.ws + WS_CTL + CTL_SS);
    for (int r = gw; r < M; r += ngw) {
        const float* xrow = r < SEQ ? P.x_prompt + (size_t)r * D : P.x_sample + (size_t)(r - SEQ) * D;
        x_row_init(xrow, HB2 + (size_t)r * D, H + (size_t)r * D, ss0 + r, lane);
    }
    const size_t gt = (size_t)blockIdx.x * 512 + tid, gs = (size_t)gridDim.x * 512;
    bf16* PBB = (bf16*)(P.ws + WS_PBB);
    for (size_t i = gt; i < (size_t)2 * M * PLE / 4; i += gs) {
        const size_t e = i * 4; const int l = (int)(e / ((size_t)M * PLE)); const size_t r = e % ((size_t)M * PLE); f32x4 v;
        if (r < (size_t)SEQ * PLE) v = *(const f32x4*)(P.p_prompt + (size_t)l * SEQ * PLE + r); else v = *(const f32x4*)(P.p_sample + (size_t)l * NSAMP * PLE + (r - (size_t)SEQ * PLE));
        uint2 w; w.x = pk2(v.x, v.y); w.y = pk2(v.z, v.w); *(uint2*)(PBB + e) = w;
    }
    float* CS = (float*)(P.ws + WS_CS);
    for (size_t i = gt; i < (size_t)SEQ * 64; i += gs) {
        const int pos = (int)(i >> 6), d = (int)(i & 63);
        const double inv = pow(10000.0, -(double)d / 64.0); const double ang = (double)pos * inv;
        CS[2 * i] = (float)cos(ang); CS[2 * i + 1] = (float)sin(ang);
    }
}

__device__ __forceinline__ void ld16_bf16(const bf16* p, f32x4 (&o)[4]) {
    const v4u a = *(const v4u*)p, b = *(const v4u*)(p + 8);
    o[0] = (f32x4){bf2f(a.x & 0xffffu), bf2f(a.x >> 16), bf2f(a.y & 0xffffu), bf2f(a.y >> 16)}; o[1] = (f32x4){bf2f(a.z & 0xffffu), bf2f(a.z >> 16), bf2f(a.w & 0xffffu), bf2f(a.w >> 16)};
    o[2] = (f32x4){bf2f(b.x & 0xffffu), bf2f(b.x >> 16), bf2f(b.y & 0xffffu), bf2f(b.y >> 16)}; o[3] = (f32x4){bf2f(b.z & 0xffffu), bf2f(b.z >> 16), bf2f(b.w & 0xffffu), bf2f(b.w >> 16)};
}
__device__ __forceinline__ void ld16_f32(const float* p, f32x4 (&o)[4]) {
#pragma unroll
    for (int j = 0; j < 4; ++j) o[j] = *(const f32x4*)(p + 4 * j);
}
__device__ __forceinline__ void ph_attn_naive(const Params& P, int l, int wave_s) {
    const bf16* PROJ = (const bf16*)(P.ws + WS_BIG); bf16* MIXB = (bf16*)(P.ws + WS_MIXB);
    const int nP = SEQ * 16 * 4, nS = NSAMP * 16 * 4;
    const int tid = opaque_tid(wave_s);
    for (int it = nP + blockIdx.x * 512 + tid; it < nP + nS; it += gridDim.x * 512) {
        const bool sample = it >= nP; int row, hq, c = 0, b = 0, qi = 0; const int part = it & 3;
        if (!sample) { const int q = (it >> 2) & 63; hq = (it >> 8) & 15; c = it >> 12; row = c * 64 + q; }
        else { const int j = it - nP; qi = (j >> 2) & 15; hq = (j >> 6) & 15; b = j >> 10; row = SEQ + b * 16 + qi; }
        const int kh = hq >> 2; const float sink = P.attn_sink[l * 16 + hq];
        f32x4 q[4], acc[4];
        ld16_bf16(PROJ + (size_t)row * INW + hq * 64 + part * 16, q);
#pragma unroll
        for (int d4 = 0; d4 < 4; ++d4) acc[d4] = (f32x4){0.f, 0.f, 0.f, 0.f};
        float m = sink, ls = 1.f;
        const int nk = sample ? 144 : 192;
#pragma unroll 1
        for (int s = 0; s < nk; ++s) {
            f32x4 kk[4], vv[4]; int rel;
            if (!sample) { const int kpos = c * 64 - 128 + s; if (kpos < 0) continue; rel = kpos - row;
                const bf16* kp = PROJ + (size_t)kpos * INW + 1024 + kh * 64 + part * 16; ld16_bf16(kp, kk); ld16_bf16(kp + 256, vv); }
            else { rel = s - 128 - qi;
                if (s < 128) { const size_t o = ((((size_t)l * DEC_B + b) * 128 + s) * 4 + kh) * 64 + part * 16; ld16_f32(P.cache_k + o, kk); ld16_f32(P.cache_v + o, vv); }
                else { const bf16* kp = PROJ + (size_t)(SEQ + b * 16 + (s - 128)) * INW + 1024 + kh * 64 + part * 16; ld16_bf16(kp, kk); ld16_bf16(kp + 256, vv); } }
            float dot = 0.f;
#pragma unroll
            for (int d4 = 0; d4 < 4; ++d4) dot += (q[d4].x * kk[d4].x + q[d4].y * kk[d4].y) + (q[d4].z * kk[d4].z + q[d4].w * kk[d4].w);
            dot += __shfl_xor(dot, 1); dot += __shfl_xor(dot, 2);
            const float sc = dot * 0.125f + P.rel_bias[t5_bucket(rel) * 16 + hq];
            const float mn = fmaxf(m, sc), corr = __expf(m - mn), p = __expf(sc - mn);
            ls = ls * corr + p; m = mn;
#pragma unroll
            for (int d4 = 0; d4 < 4; ++d4) acc[d4] = acc[d4] * corr + vv[d4] * p;
        }
        const float inv = 1.f / ls;
        v4u w0, w1;
        w0.x = pk2(acc[0].x * inv, acc[0].y * inv); w0.y = pk2(acc[0].z * inv, acc[0].w * inv); w0.z = pk2(acc[1].x * inv, acc[1].y * inv); w0.w = pk2(acc[1].z * inv, acc[1].w * inv);
        w1.x = pk2(acc[2].x * inv, acc[2].y * inv); w1.y = pk2(acc[2].z * inv, acc[2].w * inv); w1.z = pk2(acc[3].x * inv, acc[3].y * inv); w1.w = pk2(acc[3].z * inv, acc[3].w * inv);
        bf16* op = MIXB + (size_t)row * D + hq * 64 + part * 16; *(v4u*)op = w0; *(v4u*)(op + 8) = w1;
    }
}
typedef short bf16x8 __attribute__((ext_vector_type(8)));
__device__ __forceinline__ f32x4 mma_blk(const LAS bf16* F, int ldf, const LAS bf16* S, int lds_, int kd, f32x4 acc, int fr, int fq) {
    for (int k = 0; k < kd; k += 32) {
        const bf16x8 a = *(const LAS bf16x8*)(F + fr * ldf + k + fq * 8);
        const bf16x8 b = *(const LAS bf16x8*)(S + fr * lds_ + k + fq * 8);
        acc = __builtin_amdgcn_mfma_f32_16x16x32_bf16(a, b, acc, 0, 0, 0);
    }
    return acc;
}
__device__ __forceinline__ float grp16_max(float v) { v = fmaxf(v, __shfl_xor(v, 1)); v = fmaxf(v, __shfl_xor(v, 2)); v = fmaxf(v, __shfl_xor(v, 4)); v = fmaxf(v, __shfl_xor(v, 8)); return v; }
__device__ __forceinline__ float grp16_sum(float v) { v += __shfl_xor(v, 1); v += __shfl_xor(v, 2); v += __shfl_xor(v, 4); v += __shfl_xor(v, 8); return v; }

__device__ __forceinline__ void attn_prompt_unit(const Params& P, int l, int c, int kh, LAS unsigned char* lds, int tid) {
    const bf16* PROJ = (const bf16*)(P.ws + WS_BIG); bf16* MIXB = (bf16*)(P.ws + WS_MIXB);
    LAS bf16* Ks = (LAS bf16*)lds;
    LAS bf16* Vt = (LAS bf16*)(lds + 27648);
    LAS bf16* Pw = (LAS bf16*)(lds + 53248);
    LAS float* LUT = (LAS float*)(lds + 104448);
    const int lane = tid & 63, w = tid >> 6, fr = lane & 15, fq = lane >> 4;
    const v4u zero4 = (v4u){0u, 0u, 0u, 0u};
#pragma unroll
    for (int i = 0; i < 3; ++i) { const int idx = tid + i * 512, key = idx >> 3, ch = idx & 7; const int kpos = c * 64 - 128 + key;
        v4u v = zero4; if (kpos >= 0) v = *(const v4u*)(PROJ + (size_t)kpos * INW + 1024 + kh * 64 + ch * 8);
        *(LAS v4u*)(Ks + key * 72 + ch * 8) = v; }
#pragma unroll
    for (int grp = 0; grp < 3; ++grp) { const int key = grp * 64 + lane, kpos = c * 64 - 128 + key;
        v4u v = zero4; if (kpos >= 0) v = *(const v4u*)(PROJ + (size_t)kpos * INW + 1280 + kh * 64 + w * 8);
        LAS bf16* d = Vt + (w * 8) * 200 + key;
        d[0 * 200] = (bf16)(v.x & 0xffffu); d[1 * 200] = (bf16)(v.x >> 16); d[2 * 200] = (bf16)(v.y & 0xffffu); d[3 * 200] = (bf16)(v.y >> 16);
        d[4 * 200] = (bf16)(v.z & 0xffffu); d[5 * 200] = (bf16)(v.z >> 16); d[6 * 200] = (bf16)(v.w & 0xffffu); d[7 * 200] = (bf16)(v.w >> 16); }
    for (int t = tid; t < 1020; t += 512) { const int g = t / 255, idx = t % 255; LUT[g * 256 + idx] = P.rel_bias[t5_bucket(idx - 191) * 16 + kh * 4 + g]; }
    __syncthreads();
#pragma unroll 1
    for (int pass = 0; pass < 2; ++pass) {
        const int r0 = (2 * w + pass) * 16, g = r0 >> 6, hq = kh * 4 + g; const float sink = P.attn_sink[l * 16 + hq];
        bf16x8 qf[2];
        { const int q = (r0 + fr) & 63; const bf16* qp = PROJ + (size_t)(c * 64 + q) * INW + hq * 64 + fq * 8; qf[0] = *(const bf16x8*)qp; qf[1] = *(const bf16x8*)(qp + 32); }
        f32x4 acc[12];
#pragma unroll
        for (int kb = 0; kb < 12; ++kb) { acc[kb] = (f32x4){0.f, 0.f, 0.f, 0.f};
#pragma unroll
            for (int ks = 0; ks < 2; ++ks) { const bf16x8 b = *(const LAS bf16x8*)(Ks + (kb * 16 + fr) * 72 + ks * 32 + fq * 8); acc[kb] = __builtin_amdgcn_mfma_f32_16x16x32_bf16(qf[ks], b, acc[kb], 0, 0, 0); } }
        LAS bf16* pw = Pw + w * (16 * 200);
#pragma unroll
        for (int reg = 0; reg < 4; ++reg) {
            const int q = (r0 + fq * 4 + reg) & 63; float mx = -INFINITY;
#pragma unroll
            for (int kb = 0; kb < 12; ++kb) { const int key = kb * 16 + fr; float s = acc[kb][reg] * 0.125f + LUT[g * 256 + key - q + 63]; if (c * 64 - 128 + key < 0) s = -INFINITY; acc[kb][reg] = s; mx = fmaxf(mx, s); }
            const float m = fmaxf(grp16_max(mx), sink); float sum = 0.f;
#pragma unroll
            for (int kb = 0; kb < 12; ++kb) { const float p = __expf(acc[kb][reg] - m); acc[kb][reg] = p; sum += p; }
            const float inv = 1.f / (grp16_sum(sum) + __expf(sink - m));
#pragma unroll
            for (int kb = 0; kb < 12; ++kb) pw[(fq * 4 + reg) * 200 + kb * 16 + fr] = (bf16)f2bf(acc[kb][reg] * inv);
        }
        LDS_WAIT(); asm volatile("" ::: "memory");
        f32x4 o[4];
#pragma unroll
        for (int db = 0; db < 4; ++db) o[db] = mma_blk(Vt + db * 16 * 200, 200, pw, 200, 192, (f32x4){0.f, 0.f, 0.f, 0.f}, fr, fq);
        { const int q = (r0 + fr) & 63; bf16* op = MIXB + (size_t)(c * 64 + q) * D + hq * 64 + fq * 4;
#pragma unroll
            for (int db = 0; db < 4; ++db) { uint2 wv; wv.x = pk2(o[db][0], o[db][1]); wv.y = pk2(o[db][2], o[db][3]); *(uint2*)(op + db * 16) = wv; } }
        LDS_WAIT(); asm volatile("" ::: "memory");
    }
    __syncthreads();
}

__device__ __forceinline__ void ret_upd_unit(const Params& P, int c, int h, LAS unsigned char* lds, int tid) {
    const bf16* PROJ = (const bf16*)(P.ws + WS_BIG); bf16* UPDt = (bf16*)(P.ws + WS_UPD);
    LAS bf16* Kt = (LAS bf16*)lds;
    LAS bf16* Vzt = (LAS bf16*)(lds + 18432);
    const int lane = tid & 63, w = tid >> 6, fr = lane & 15, fq = lane >> 4;
    const float lg2 = log2f(1.f - exp2f(-5.f - (float)h));
    const float zeta = exp2f((float)(63 - lane) * lg2);
    const bf16* rowp = PROJ + (size_t)(c * 64 + lane) * INW + h * 128;
#pragma unroll
    for (int i = 0; i < 2; ++i) { const int cc = w + 8 * i;
        const v4u kv = *(const v4u*)(rowp + 2560 + cc * 8), vv = *(const v4u*)(rowp + 3584 + cc * 8);
        LAS bf16* dk = Kt + (cc * 8) * 72 + lane; LAS bf16* dv = Vzt + (cc * 8) * 72 + lane;
        dk[0 * 72] = (bf16)(kv.x & 0xffffu); dk[1 * 72] = (bf16)(kv.x >> 16); dk[2 * 72] = (bf16)(kv.y & 0xffffu); dk[3 * 72] = (bf16)(kv.y >> 16);
        dk[4 * 72] = (bf16)(kv.z & 0xffffu); dk[5 * 72] = (bf16)(kv.z >> 16); dk[6 * 72] = (bf16)(kv.w & 0xffffu); dk[7 * 72] = (bf16)(kv.w >> 16);
        dv[0 * 72] = (bf16)f2bf(bf2f(vv.x & 0xffffu) * zeta); dv[1 * 72] = (bf16)f2bf(bf2f(vv.x >> 16) * zeta); dv[2 * 72] = (bf16)f2bf(bf2f(vv.y & 0xffffu) * zeta); dv[3 * 72] = (bf16)f2bf(bf2f(vv.y >> 16) * zeta);
        dv[4 * 72] = (bf16)f2bf(bf2f(vv.z & 0xffffu) * zeta); dv[5 * 72] = (bf16)f2bf(bf2f(vv.z >> 16) * zeta); dv[6 * 72] = (bf16)f2bf(bf2f(vv.w & 0xffffu) * zeta); dv[7 * 72] = (bf16)f2bf(bf2f(vv.w >> 16) * zeta); }
    __syncthreads();
    bf16* up = UPDt + ((size_t)(c * 8 + h) * 128) * 128;
#pragma unroll
    for (int eb = 0; eb < 8; ++eb) {
        const f32x4 a = mma_blk(Kt + (w * 16) * 72, 72, Vzt + (eb * 16) * 72, 72, 64, (f32x4){0.f, 0.f, 0.f, 0.f}, fr, fq);
        uint2 wv; wv.x = pk2(a[0], a[1]); wv.y = pk2(a[2], a[3]);
        *(uint2*)(up + (size_t)(eb * 16 + fr) * 128 + w * 16 + fq * 4) = wv;
    }
    __syncthreads();
}
__device__ __forceinline__ void ph_ret_scan(const Params& P, int l, int wave_s) {
    const bf16* UPDt = (const bf16*)(P.ws + WS_UPD); bf16* SprevT = (bf16*)(P.ws + WS_UB);
    const int tid = opaque_tid(wave_s);
    for (int pr = blockIdx.x * 512 + tid; pr < 8 * 128 * 64; pr += gridDim.x * 512) {
        const int h = pr >> 13, e = (pr >> 6) & 127, s2 = (pr & 63) * 2;
        const float g64 = exp2f(64.f * log2f(1.f - exp2f(-5.f - (float)h)));
        const size_t off = ((size_t)h * 128 + e) * 128 + s2; const size_t cstride = (size_t)8 * 128 * 128;
        float s0 = 0.f, s1 = 0.f;
#pragma unroll 1
        for (int c0 = 0; c0 < 128; c0 += 8) {
            unsigned u[8];
#pragma unroll
            for (int k = 0; k < 8; ++k) u[k] = *(const unsigned*)(UPDt + off + (size_t)(c0 + k) * cstride);
#pragma unroll
            for (int k = 0; k < 8; ++k) { *(unsigned*)(SprevT + off + (size_t)(c0 + k) * cstride) = pk2(s0, s1); s0 = g64 * s0 + bf2f(u[k] & 0xffffu); s1 = g64 * s1 + bf2f(u[k] >> 16); }
        }
        float* so = P.out + OFF_NSP + ((size_t)l * 8 + h) * 16384;
        { const int od0 = (s2 >> 1), od1 = (s2 >> 1) + 64; so[od0 * 128 + e] = s0; so[od1 * 128 + e] = s1; }
    }
}
__device__ __forceinline__ void ret_out_unit(const Params& P, int l, int c, int h, LAS unsigned char* lds, int tid) {
    const bf16* PROJ = (const bf16*)(P.ws + WS_BIG); const bf16* SprevT = (const bf16*)(P.ws + WS_UB); bf16* MIXB = (bf16*)(P.ws + WS_MIXB);
    LAS bf16* Qs = (LAS bf16*)lds;
    LAS bf16* Ks = (LAS bf16*)(lds + 17408);
    LAS bf16* Vt = (LAS bf16*)(lds + 34816);
    LAS bf16* St = (LAS bf16*)(lds + 53248);
    LAS bf16* Pm = (LAS bf16*)(lds + 88064);
    LAS float* Of = (LAS float*)(lds + 97280);
    const int lane = tid & 63, w = tid >> 6, fr = lane & 15, fq = lane >> 4;
    const float lg2 = log2f(1.f - exp2f(-5.f - (float)h));
#pragma unroll
    for (int i = 0; i < 2; ++i) { const int idx = tid + i * 512, r = idx >> 4, ch = idx & 15; const bf16* rp = PROJ + (size_t)(c * 64 + r) * INW + h * 128 + ch * 8;
        *(LAS v4u*)(Qs + r * 136 + ch * 8) = *(const v4u*)(rp + 1536); *(LAS v4u*)(Ks + r * 136 + ch * 8) = *(const v4u*)(rp + 2560); }
    { const bf16* sp = SprevT + ((size_t)(c * 8 + h) * 128) * 128;
#pragma unroll
      for (int i = 0; i < 4; ++i) { const int idx = tid + i * 512, e = idx >> 4, ch = idx & 15; *(LAS v4u*)(St + e * 136 + ch * 8) = *(const v4u*)(sp + (size_t)e * 128 + ch * 8); } }
    { const bf16* rowp = PROJ + (size_t)(c * 64 + lane) * INW + 3584 + h * 128;
#pragma unroll
      for (int i = 0; i < 2; ++i) { const int cc = w + 8 * i; const v4u vv = *(const v4u*)(rowp + cc * 8); LAS bf16* dv = Vt + (cc * 8) * 72 + lane;
        dv[0 * 72] = (bf16)(vv.x & 0xffffu); dv[1 * 72] = (bf16)(vv.x >> 16); dv[2 * 72] = (bf16)(vv.y & 0xffffu); dv[3 * 72] = (bf16)(vv.y >> 16);
        dv[4 * 72] = (bf16)(vv.z & 0xffffu); dv[5 * 72] = (bf16)(vv.z >> 16); dv[6 * 72] = (bf16)(vv.w & 0xffffu); dv[7 * 72] = (bf16)(vv.w >> 16); } }
    __syncthreads();
    const int ib = w >> 1;
#pragma unroll
    for (int jj = 0; jj < 2; ++jj) { const int jb = (w & 1) * 2 + jj;
        const f32x4 a = mma_blk(Qs + (ib * 16) * 136, 136, Ks + (jb * 16) * 136, 136, 128, (f32x4){0.f, 0.f, 0.f, 0.f}, fr, fq);
#pragma unroll
        for (int reg = 0; reg < 4; ++reg) { const int i = ib * 16 + fq * 4 + reg, j = jb * 16 + fr; const float v = i >= j ? a[reg] * exp2f((float)(i - j) * lg2) : 0.f; Pm[i * 72 + j] = (bf16)f2bf(v); } }
    __syncthreads();
#pragma unroll
    for (int ee = 0; ee < 4; ++ee) { const int eb = (w & 1) * 4 + ee;
        const f32x4 pv = mma_blk(Pm + (ib * 16) * 72, 72, Vt + (eb * 16) * 72, 72, 64, (f32x4){0.f, 0.f, 0.f, 0.f}, fr, fq);
        const f32x4 x = mma_blk(Qs + (ib * 16) * 136, 136, St + (eb * 16) * 136, 136, 128, (f32x4){0.f, 0.f, 0.f, 0.f}, fr, fq);
#pragma unroll
        for (int reg = 0; reg < 4; ++reg) { const int i = ib * 16 + fq * 4 + reg; Of[i * 132 + eb * 16 + fr] = pv[reg] + exp2f((float)(i + 1) * lg2) * x[reg]; } }
    __syncthreads();
    { const int i = tid >> 3, e0 = (tid & 7) * 16; f32x4 v[4]; float ss = 0.f;
#pragma unroll
      for (int k = 0; k < 4; ++k) { v[k] = *(const LAS f32x4*)(Of + i * 132 + e0 + 4 * k); ss += (v[k].x * v[k].x + v[k].y * v[k].y) + (v[k].z * v[k].z + v[k].w * v[k].w); }
      ss += __shfl_xor(ss, 1); ss += __shfl_xor(ss, 2); ss += __shfl_xor(ss, 4);
      const float rs = rsqrtf(ss * (1.f / 128.f) + EPS);
      f32x4 gt[4]; ld16_bf16(PROJ + (size_t)(c * 64 + i) * INW + 4608 + h * 128 + e0, gt);
      const float* gn = P.ret_gain + l * 1024 + h * 128 + e0; v4u w0, w1; f32x4 r[4];
#pragma unroll
      for (int k = 0; k < 4; ++k) { const f32x4 gg = *(const f32x4*)(gn + 4 * k); r[k] = gt[k] * (v[k] * rs * gg); }
      w0.x = pk2(r[0].x, r[0].y); w0.y = pk2(r[0].z, r[0].w); w0.z = pk2(r[1].x, r[1].y); w0.w = pk2(r[1].z, r[1].w);
      w1.x = pk2(r[2].x, r[2].y); w1.y = pk2(r[2].z, r[2].w); w1.z = pk2(r[3].x, r[3].y); w1.w = pk2(r[3].z, r[3].w);
      bf16* op = MIXB + (size_t)(c * 64 + i) * D + 1024 + h * 128 + e0; *(v4u*)op = w0; *(v4u*)(op + 8) = w1; }
    __syncthreads();
}
__device__ __forceinline__ void ret_sample_item(const Params& P, int l, int b, int h, LAS unsigned char* lds, int tid) {
    const bf16* PROJ = (const bf16*)(P.ws + WS_BIG); bf16* MIXB = (bf16*)(P.ws + WS_MIXB);
    LAS float* sq = (LAS float*)lds; LAS float* sk = sq + 16 * 128; LAS float* so = sk + 16 * 128;
    const int row0 = SEQ + b * 16;
    const float gamma = 1.f - exp2f(-5.f - (float)h);
    float S[64]; const int e = tid & 127, half = (tid >> 7) & 1;
    const float* s0 = P.state_ret + (((size_t)l * DEC_B + b) * 8 + h) * 16384;
#pragma unroll
    for (int d = 0; d < 64; ++d) { const int s = half * 64 + d, od = (s >> 1) + 64 * (s & 1); S[d] = s0[od * 128 + e]; }
    for (int i = tid; i < 4096; i += 512) { const int tt = i >> 8, dd = i & 255, which = dd >> 7, d = dd & 127;
        const float v = bf2f(PROJ[(size_t)(row0 + tt) * INW + (which ? 2560 : 1536) + h * 128 + d]); (which ? sk : sq)[tt * 128 + d] = v; }
    __syncthreads();
    if (tid < 256) {
#pragma unroll 1
        for (int tt = 0; tt < 16; ++tt) {
            const float v = bf2f(PROJ[(size_t)(row0 + tt) * INW + 3584 + h * 128 + e]); float o = 0.f;
#pragma unroll
            for (int d = 0; d < 64; ++d) { S[d] = gamma * S[d] + sk[tt * 128 + half * 64 + d] * v; o += sq[tt * 128 + half * 64 + d] * S[d]; }
            so[(tt * 2 + half) * 128 + e] = o;
        }
        float* sp = P.out + OFF_NSS + (((size_t)l * DEC_B + b) * 8 + h) * 16384;
#pragma unroll
        for (int d = 0; d < 64; ++d) { const int s = half * 64 + d, od = (s >> 1) + 64 * (s & 1); sp[od * 128 + e] = S[d]; }
    }
    __syncthreads();
    { const int tt = tid >> 5, e0 = (tid & 31) * 4; float o[4]; float ss = 0.f;
#pragma unroll
      for (int k = 0; k < 4; ++k) { o[k] = so[(tt * 2) * 128 + e0 + k] + so[(tt * 2 + 1) * 128 + e0 + k]; ss += o[k] * o[k]; }
      ss += __shfl_xor(ss, 1); ss += __shfl_xor(ss, 2); ss += __shfl_xor(ss, 4); ss += __shfl_xor(ss, 8); ss += __shfl_xor(ss, 16);
      const float rs = rsqrtf(ss * (1.f / 128.f) + EPS);
      const bf16* gp = PROJ + (size_t)(row0 + tt) * INW + 4608 + h * 128 + e0; const float* gn = P.ret_gain + l * 1024 + h * 128 + e0;
      uint2 wv; wv.x = pk2(bf2f(gp[0]) * (o[0] * rs * gn[0]), bf2f(gp[1]) * (o[1] * rs * gn[1])); wv.y = pk2(bf2f(gp[2]) * (o[2] * rs * gn[2]), bf2f(gp[3]) * (o[3] * rs * gn[3]));
      *(uint2*)(MIXB + (size_t)(row0 + tt) * D + 1024 + h * 128 + e0) = wv; }
    __syncthreads();
}
__device__ __forceinline__ void ph_mix1(const Params& P, int l, LAS unsigned char* lds, int wave_s) {
    const int tid = opaque_tid(wave_s);
    const int G = gridDim.x, bx = blockIdx.x;
    for (int u = bx; u < 512; u += G) attn_prompt_unit(P, l, u >> 2, u & 3, lds, tid);
    for (int u = bx; u < 1024; u += G) ret_upd_unit(P, u >> 3, u & 7, lds, tid);
    for (int u = bx; u < 256; u += G) ret_sample_item(P, l, u >> 3, u & 7, lds, tid);
}
__device__ __forceinline__ void ph_mix3(const Params& P, int l, LAS unsigned char* lds, int wave_s) {
    const int tid = opaque_tid(wave_s);
    for (int u = blockIdx.x; u < 1024; u += gridDim.x) ret_out_unit(P, l, u >> 3, u & 7, lds, tid);
}
#define GEMM_PHASE(EPI) pg8::gemm_phase<EPI, pg8::StaticOrder, true, true>(lds, g, S, E, wave_s)
#define GRID_BAR() xcd_barrier(bar)
template <int l> __device__ __forceinline__ void layer_body(const Params& P, LAS unsigned char* lds, const XcdBarrier& bar, int wave_s) {
    const int G = gridDim.x, bx = blockIdx.x;
    float* H = (float*)(P.ws + WS_H); bf16* HBa = (bf16*)(P.ws + WS_UB); bf16* HBb = (bf16*)(P.ws + WS_HB2); bf16* MIXB = (bf16*)(P.ws + WS_MIXB);
    bf16* PROJB = (bf16*)(P.ws + WS_BIG); bf16* FFB = (bf16*)(P.ws + WS_BIG); float* PL = (float*)(P.ws + WS_BIG); bf16* PBB = (bf16*)(P.ws + WS_PBB);
    const float* CS = (const float*)(P.ws + WS_CS); float* SS = (float*)(P.ws + WS_CTL + CTL_SS);
    const unsigned char* wl = P.ws + WS_W + (size_t)l * WL_STRIDE;
    { pg8::Gemm g{HBb, (const bf16*)(wl + WL_IN), M, INW, D}; pg8::StaticOrder S; S.init(M, INW, G, bx); pg8::EpiProj E{PROJB, CS, P.out, l, SS + (3 * l) * M}; GEMM_PHASE(pg8::EpiProj); }
    GRID_BAR();
    ph_attn_naive(P, l, wave_s);
    ph_mix1(P, l, lds, wave_s); GRID_BAR();
    ph_ret_scan(P, l, wave_s); GRID_BAR();
    ph_mix3(P, l, lds, wave_s); GRID_BAR();
    { pg8::Gemm g{MIXB, (const bf16*)(wl + WL_OUT), M, D, D}; pg8::StaticOrder S; S.init(M, D, G, bx); pg8::EpiRes E{H, HBa, SS + (3 * l + 1) * M}; GEMM_PHASE(pg8::EpiRes); }
    GRID_BAR();
    { pg8::Gemm g{HBa, (const bf16*)(wl + WL_UP), M, FFW, D}; pg8::StaticOrder S; S.init(M, FFW, G, bx); pg8::EpiBf16<1> E{FFB, FFW, SS + (3 * l + 1) * M}; GEMM_PHASE(pg8::EpiBf16<1>); }
    GRID_BAR();
    { pg8::Gemm g{FFB, (const bf16*)(wl + WL_DOWN), M, D, FFW}; pg8::StaticOrder S; S.init(M, D, G, bx); pg8::EpiRes E{H, HBa, SS + (3 * l + 2) * M}; GEMM_PHASE(pg8::EpiRes); }
    GRID_BAR();
    { pg8::Gemm g{PBB + (size_t)l * M * PLE, (const bf16*)(wl + WL_PLE), M, D, PLE}; pg8::StaticOrder S; S.init(M, D, G, bx); pg8::EpiF32 E{PL}; GEMM_PHASE(pg8::EpiF32); }
    { pg8::Gemm g{HBa, (const bf16*)(wl + WL_GATE), M, D, D}; pg8::StaticOrder S; S.init(M, D, G, bx); pg8::EpiGate E{H, PL, HBb, SS + (3 * l + 2) * M, SS + (3 * l + 3) * M}; GEMM_PHASE(pg8::EpiGate); }
    GRID_BAR();
}
__global__ void __launch_bounds__(512, 2) k_mega(Params P) {
    extern __shared__ __attribute__((aligned(16))) unsigned char lds_raw[];
    LAS unsigned char* lds = (LAS unsigned char*)lds_raw;
    cg::grid_group grid = cg::this_grid();
    const int wave_s = __builtin_amdgcn_readfirstlane((int)(threadIdx.x >> 6));
    volatile LAS unsigned* misc = (volatile LAS unsigned*)(lds + LDS_MISC_OFF);
    if (threadIdx.x < 64) misc[threadIdx.x] = 0u;
    __syncthreads();
    XcdBarrier bar = xcd_barrier_post((unsigned*)(P.ws + WS_CTL + CTL_BAR), misc + 8); bar.w = wave_s;
    ph_prologue(P, lds, wave_s);
    grid.sync();
    layer_body<0>(P, lds, bar, wave_s);
    layer_body<1>(P, lds, bar, wave_s);
    ph_final_norm(P, wave_s);
}

extern "C" void kernel_launch(void* const* d_in, const int* in_sizes, int n_in, void* d_out, int out_size, void* d_ws, size_t ws_size, hipStream_t stream) {
    static int grid_blocks = 0;
    if (!grid_blocks) {
        int dev = 0, cus = 0, per_cu = 0;
        (void)hipGetDevice(&dev);
        (void)hipDeviceGetAttribute(&cus, hipDeviceAttributeMultiprocessorCount, dev);
        (void)hipFuncSetAttribute((const void*)k_mega, hipFuncAttributeMaxDynamicSharedMemorySize, LDS_BYTES);
        (void)hipOccupancyMaxActiveBlocksPerMultiprocessor(&per_cu, (const void*)k_mega, 512, LDS_BYTES);
        if (per_cu != 1) fprintf(stderr, "kernel_launch: occupancy query says %d blocks per CU (expected 1)\n", per_cu);
        grid_blocks = cus;
        if (ws_size < WS_HB2 + 34 * MiB) fprintf(stderr, "kernel_launch: workspace too small: %zu\n", ws_size);
    }
    (void)hipMemsetAsync((unsigned char*)d_ws + WS_CTL, 0, CTL_ZERO_BYTES, stream);
    Params P{};
    const float** pp = (const float**)&P;
    for (int i = 0; i < 20; ++i) pp[i] = (const float*)d_in[i];
    P.out = (float*)d_out; P.ws = (unsigned char*)d_ws;
    void* args[] = {&P};
    hipError_t e = hipLaunchCooperativeKernel((const void*)k_mega, dim3(grid_blocks), dim3(512), args, LDS_BYTES, stream);
    if (e != hipSuccess) fprintf(stderr, "cooperative launch failed: %s (grid %d)\n", hipGetErrorString(e), grid_blocks);
}
```

```cpp
#include <hip/hip_runtime.h>
#include <hip/hip_cooperative_groups.h>
#include <cstdint>
#include <cstdio>
namespace cg = cooperative_groups;

constexpr int D = 2048, SEQ = 8192, NSAMP = 512, M = SEQ + NSAMP, INW = 5632, FFW = 8192, PLE = 256;
constexpr int DEC_B = 32, DEC_L = 16;
constexpr float EPS = 1e-6f;
constexpr size_t OFF_Y = 0;
constexpr size_t OFF_NKP = (size_t)M * D;
constexpr size_t OFF_NVP = OFF_NKP + 2 * 128 * 256;
constexpr size_t OFF_NSP = OFF_NVP + 2 * 128 * 256;
constexpr size_t OFF_NKS = OFF_NSP + 2 * 8 * 16384;
constexpr size_t OFF_NVS = OFF_NKS + 2 * 512 * 256;
constexpr size_t OFF_NSS = OFF_NVS + 2 * 512 * 256;
constexpr size_t MiB = 1u << 20;
constexpr size_t WS_H = 0;
constexpr size_t WS_UB = 68 * MiB;
constexpr size_t WS_MIXB = 102 * MiB;
constexpr size_t WS_BIG = 136 * MiB;
constexpr size_t WS_UPD = WS_BIG + 94 * MiB;
constexpr size_t WS_PBB = 272 * MiB;
constexpr size_t WS_CS = 281 * MiB;
constexpr size_t WS_CTL = 285 * MiB;
constexpr size_t CTL_BAR = 0, CTL_SS = 128 * 1024, CTL_ZERO_BYTES = 512 * 1024;
constexpr size_t WS_W = 286 * MiB;
constexpr size_t WS_HB2 = 492 * MiB;
constexpr size_t WL_IN = 0, WL_OUT = 22 * MiB, WL_UP = 30 * MiB, WL_DOWN = 62 * MiB, WL_GATE = 94 * MiB, WL_PLE = 102 * MiB, WL_STRIDE = 103 * MiB;
constexpr int LDS_MISC_OFF = 131072 + 1024;
constexpr int LDS_BYTES = 147456;

struct Params {
    const float *x_prompt, *x_sample, *cache_k, *cache_v, *state_ret, *p_prompt, *p_sample, *rel_bias, *norm_mix, *w_in, *attn_sink,
        *ret_gain, *w_out, *norm_mlp, *w_up, *w_down, *norm_ple, *w_gate, *w_ple, *norm_final;
    float* out; unsigned char* ws;
};


namespace pg8 {
#define PG8_LAS __attribute__((address_space(3)))
typedef unsigned short bf16_t;
typedef short bf16x8 __attribute__((ext_vector_type(8)));
typedef float f32x4 __attribute__((ext_vector_type(4)));
typedef unsigned u32x4 __attribute__((ext_vector_type(4)));
constexpr int BM = 256, BK = 64, HALF = 128, HTB = HALF * BK * 2  , STAGE_BYTES = 8 * HTB, NXCD = 8, WGM = 8;

__host__ __device__ __forceinline__ int lds_byte(int r, int c) { const int st = (r >> 4) * 2 + (c >> 5), rr = r & 15, cc = c & 31, ob = rr * 64 + cc * 2; return st * 1024 + (ob ^ (((ob >> 9) & 1) << 5)); }
__host__ __device__ __forceinline__ void stage_rc(int b, int& R, int& C) { const int st = b / 1024, sb = b % 1024, swz = sb ^ (((sb >> 9) & 1) << 5); R = (st >> 1) * 16 + swz / 64; C = (st & 1) * 32 + (swz % 64) / 2; }
__host__ __device__ __forceinline__ int perm32(int rho) { const int n = rho >> 4, i = rho & 15; return 8 * (i >> 2) + 4 * n + (i & 3); }

struct Unit { int pm, pn; };
struct Gemm { const bf16_t* A; const bf16_t* Bt; int M, N, K; };

struct StaticOrder {
    int nM, nN, nwg, G, c;
    __host__ __device__ void init(int M, int N, int G_, int c_) { nM = M / BM; nN = N / BM; nwg = nM * nN; G = G_; c = c_; }
    __host__ __device__ bool next(int i, Unit& u) const {
        const long L = (long)i * G + c; if (L >= nwg) return false;
        int wgid = (int)L; { const int q = nwg / NXCD, r = nwg % NXCD, xcd = wgid % NXCD, off = wgid / NXCD; wgid = (xcd < r ? xcd * (q + 1) : r * (q + 1) + (xcd - r) * q) + off; }
        const int nig = WGM * nN, gid = wgid / nig, fm = gid * WGM, gsz = (nM - fm) < WGM ? (nM - fm) : WGM;
        u.pm = fm + ((wgid % nig) % gsz); u.pn = (wgid % nig) / gsz; return true;
    }
    __device__ __forceinline__ void a_ready(const Unit&) const {}
    __device__ __forceinline__ void done(const Unit&) const {}
};


__device__ __forceinline__ unsigned cvt_pk_bf16(float lo, float hi) { unsigned r; asm volatile("v_cvt_pk_bf16_f32 %0, %1, %2" : "=v"(r) : "v"(lo), "v"(hi)); return r; }
typedef float f32x2 __attribute__((ext_vector_type(2)));

__device__ __forceinline__ float rstd_of(const float* ss, int row) { return rsqrtf(__hip_atomic_load(ss + row, __ATOMIC_RELAXED, __HIP_MEMORY_SCOPE_AGENT) * (1.f / 2048.f) + 1e-6f); }
template <int ACT  > struct EpiBf16 {
    static constexpr bool PERM = true, AFTER_DRAIN = false;
    bf16_t* O; int ldc; const float* ss;
    __device__ __forceinline__ void operator()(const f32x4 (&acc)[2][2][4][2], const Unit& u, int wr, int wc, int fr, int fq) const {
        const int row0 = u.pm * BM + wr * 64 + fr, col0 = u.pn * BM + wc * 32 + 8 * fq;
#pragma unroll
        for (int ai = 0; ai < 2; ++ai)
#pragma unroll
            for (int m = 0; m < 4; ++m) { const int row = row0 + ai * HALF + m * 16; bf16_t* rowp = O + (size_t)row * ldc + col0;
                const float rs = rstd_of(ss, row);
#pragma unroll
                for (int bj = 0; bj < 2; ++bj) { f32x4 v0 = acc[ai][bj][m][0] * rs, v1 = acc[ai][bj][m][1] * rs;
                    if (ACT == 1) {
#pragma unroll
                        for (int j = 0; j < 4; ++j) { const float a = v0[j] > 0.f ? v0[j] : 0.f, b = v1[j] > 0.f ? v1[j] : 0.f; v0[j] = a * a; v1[j] = b * b; } }
                    u32x4 w; w.x = cvt_pk_bf16(v0[0], v0[1]); w.y = cvt_pk_bf16(v0[2], v0[3]); w.z = cvt_pk_bf16(v1[0], v1[1]); w.w = cvt_pk_bf16(v1[2], v1[3]);
                    *(u32x4*)(rowp + bj * HALF) = w; } }
    }
};
struct EpiProj {
    static constexpr bool PERM = true, AFTER_DRAIN = false;
    bf16_t* O; const float* CS; float* out; int layer; const float* ss;
    __device__ __forceinline__ void operator()(const f32x4 (&acc)[2][2][4][2], const Unit& u, int wr, int wc, int fr, int fq) const {
        const int pn = u.pn, row0 = u.pm * BM + wr * 64 + fr, col0 = pn * BM + wc * 32 + 8 * fq;
        const int kind = pn < 4 ? 0 : pn < 6 ? 1 : pn < 14 ? 2 : pn < 18 ? 0 : 3;
        const float rsc = (pn >= 10 && pn < 14) ? 0.08838834764831845f : 1.0f;
#pragma unroll
        for (int ai = 0; ai < 2; ++ai)
#pragma unroll
            for (int m = 0; m < 4; ++m) { const int row = row0 + ai * HALF + m * 16; bf16_t* rowp = O + (size_t)row * 5632 + col0;
                const float rs = rstd_of(ss, row);
                f32x4 cs0 = (f32x4){1.f, 0.f, 1.f, 0.f}, cs1 = cs0;
                if (kind == 2) { const int pos = row < 8192 ? row : 4096 + ((row - 8192) & 15); const float* cp = CS + ((size_t)pos * 64 + wc * 16 + fq * 4) * 2; cs0 = *(const f32x4*)cp; cs1 = *(const f32x4*)(cp + 4); }
#pragma unroll
                for (int bj = 0; bj < 2; ++bj) { f32x4 v0 = acc[ai][bj][m][0] * rs, v1 = acc[ai][bj][m][1] * rs;
                    if (kind == 2) {
                        f32x4 r0, r1;
                        r0[0] = (v0[0] * cs0[0] - v0[1] * cs0[1]) * rsc; r0[1] = (v0[1] * cs0[0] + v0[0] * cs0[1]) * rsc;
                        r0[2] = (v0[2] * cs0[2] - v0[3] * cs0[3]) * rsc; r0[3] = (v0[3] * cs0[2] + v0[2] * cs0[3]) * rsc;
                        r1[0] = (v1[0] * cs1[0] - v1[1] * cs1[1]) * rsc; r1[1] = (v1[1] * cs1[0] + v1[0] * cs1[1]) * rsc;
                        r1[2] = (v1[2] * cs1[2] - v1[3] * cs1[3]) * rsc; r1[3] = (v1[3] * cs1[2] + v1[2] * cs1[3]) * rsc;
                        v0 = r0; v1 = r1;
                    } else if (kind == 3) {
#pragma unroll
                        for (int j = 0; j < 4; ++j) { v0[j] = v0[j] / (1.f + __expf(-v0[j])); v1[j] = v1[j] / (1.f + __expf(-v1[j])); }
                    } else if (kind == 1) {
                        if (row >= 8064) { const int which = pn - 4;
                            float* dst = row < 8192 ? out + (which ? OFF_NVP : OFF_NKP) + (size_t)layer * 32768 + (size_t)(row - 8064) * 256
                                                    : out + (which ? OFF_NVS : OFF_NKS) + (size_t)layer * 131072 + (size_t)(row - 8192) * 256;
                            dst += bj * HALF + wc * 32 + 8 * fq; *(f32x4*)dst = v0; *(f32x4*)(dst + 4) = v1; }
                    }
                    u32x4 w; w.x = cvt_pk_bf16(v0[0], v0[1]); w.y = cvt_pk_bf16(v0[2], v0[3]); w.z = cvt_pk_bf16(v1[0], v1[1]); w.w = cvt_pk_bf16(v1[2], v1[3]);
                    *(u32x4*)(rowp + bj * HALF) = w; } }
    }
};
struct EpiRes {
    static constexpr bool PERM = false, AFTER_DRAIN = false;
    float* H; bf16_t* HB; float* ssq;
    __device__ __forceinline__ void operator()(const f32x4 (&acc)[2][2][4][2], const Unit& u, int wr, int wc, int fr, int fq) const {
        const int row0 = u.pm * BM + wr * 64 + fr, col0 = u.pn * BM + wc * 32 + 4 * fq;
#pragma unroll
        for (int ai = 0; ai < 2; ++ai)
#pragma unroll
            for (int m = 0; m < 4; ++m) { const int row = row0 + ai * HALF + m * 16; float* rowp = H + (size_t)row * 2048 + col0; bf16_t* bp = HB + (size_t)row * 2048 + col0; float q = 0.f;
#pragma unroll
                for (int bj = 0; bj < 2; ++bj)
#pragma unroll
                    for (int n = 0; n < 2; ++n) { f32x4* p = (f32x4*)(rowp + bj * HALF + n * 16); const f32x4 o = *p + acc[ai][bj][m][n]; *p = o;
                        q += (o[0] * o[0] + o[1] * o[1]) + (o[2] * o[2] + o[3] * o[3]);
                        uint2 w; w.x = cvt_pk_bf16(o[0], o[1]); w.y = cvt_pk_bf16(o[2], o[3]); *(uint2*)(bp + bj * HALF + n * 16) = w; }
                q += __shfl_xor(q, 16); q += __shfl_xor(q, 32);
                if (fq == 0) unsafeAtomicAdd(ssq + row, q);
                asm volatile("" ::: "memory"); }
    }
};
struct EpiF32 {
    static constexpr bool PERM = false, AFTER_DRAIN = false;
    float* C;
    __device__ __forceinline__ void operator()(const f32x4 (&acc)[2][2][4][2], const Unit& u, int wr, int wc, int fr, int fq) const {
        const int row0 = u.pm * BM + wr * 64 + fr, col0 = u.pn * BM + wc * 32 + 4 * fq;
#pragma unroll
        for (int ai = 0; ai < 2; ++ai)
#pragma unroll
            for (int m = 0; m < 4; ++m) { float* rowp = C + (size_t)(row0 + ai * HALF + m * 16) * 2048 + col0;
#pragma unroll
                for (int bj = 0; bj < 2; ++bj)
#pragma unroll
                    for (int n = 0; n < 2; ++n) *(f32x4*)(rowp + bj * HALF + n * 16) = acc[ai][bj][m][n]; }
    }
};
struct EpiGate {
    static constexpr bool PERM = false, AFTER_DRAIN = false;
    float* H; const float* PL; bf16_t* HB; const float* ss; float* ssq;
    __device__ __forceinline__ void operator()(const f32x4 (&acc)[2][2][4][2], const Unit& u, int wr, int wc, int fr, int fq) const {
        const int row0 = u.pm * BM + wr * 64 + fr, col0 = u.pn * BM + wc * 32 + 4 * fq;
#pragma unroll
        for (int ai = 0; ai < 2; ++ai)
#pragma unroll
            for (int m = 0; m < 4; ++m) { const int row = row0 + ai * HALF + m * 16; const size_t off = (size_t)row * 2048 + col0; const float rs = rstd_of(ss, row); float q = 0.f;
#pragma unroll
                for (int bj = 0; bj < 2; ++bj)
#pragma unroll
                    for (int n = 0; n < 2; ++n) { f32x4* p = (f32x4*)(H + off + bj * HALF + n * 16); const f32x4 pl = *(const f32x4*)(PL + off + bj * HALF + n * 16); const f32x4 a = acc[ai][bj][m][n] * rs; f32x4 g;
#pragma unroll
                        for (int j = 0; j < 4; ++j) g[j] = 1.f / (1.f + __expf(-a[j]));
                        const f32x4 o = *p + g * pl; *p = o;
                        q += (o[0] * o[0] + o[1] * o[1]) + (o[2] * o[2] + o[3] * o[3]);
                        uint2 w; w.x = cvt_pk_bf16(o[0], o[1]); w.y = cvt_pk_bf16(o[2], o[3]); *(uint2*)(HB + off + bj * HALF + n * 16) = w; }
                q += __shfl_xor(q, 16); q += __shfl_xor(q, 32);
                if (fq == 0) unsafeAtomicAdd(ssq + row, q);
                asm volatile("" ::: "memory"); }
    }
};


template <class Epi, class Sched, bool ALIGN_EPI = false, bool SP2 = false>
__device__ __forceinline__ void gemm_phase(PG8_LAS unsigned char* lds, const Gemm g, const Sched& S, const Epi& E, const int wave_s) {
    int tid_; asm volatile("v_mbcnt_lo_u32_b32 %0, -1, 0\n\tv_mbcnt_hi_u32_b32 %0, -1, %0" : "=v"(tid_)); tid_ += wave_s * 64;
    const int tid = tid_, wid = wave_s, lane = tid & 63, wr = wid >> 2, wc = wid & 3, fr = lane & 15, fq = lane >> 4;
    const int K = g.K, nt = K / BK;
    unsigned voffA[2], voffB[2];
#pragma unroll
    for (int i = 0; i < 2; ++i) { int R, C; stage_rc(tid * 16 + i * 8192, R, C); const int Rb = Epi::PERM ? ((R & ~31) + perm32(R & 31)) : R;
        voffA[i] = (unsigned)(R * K + C) * 2u; voffB[i] = (unsigned)(Rb * K + C) * 2u; }
    const size_t kstep = (size_t)(BK * 2);
    const size_t hstep = (size_t)HALF * K * 2;
    const size_t tstep = 2 * hstep;
    const unsigned ldsw = (unsigned)wid * 1024u;
    const int aoff = lds_byte(wr * 64 + fr, fq * 8), boff = lds_byte(wc * 32 + fr, fq * 8);
#define PG8_SA(b, h) (((b) * 2 + (h)) * HTB)
#define PG8_SB(b, h) ((4 + (b) * 2 + (h)) * HTB)
#define PG8_STAGE(bufoff, gbase, voff) do { _Pragma("unroll") for (int _i = 0; _i < 2; ++_i) \
        __builtin_amdgcn_global_load_lds((const unsigned*)((const char*)(gbase) + (voff)[_i]), (PG8_LAS unsigned*)(lds + (bufoff) + ldsw + _i * 8192), 16, 0, 0); } while (0)
#define PG8_LDA(dst, b, h) do { _Pragma("unroll") for (int m = 0; m < 4; ++m) _Pragma("unroll") for (int k = 0; k < 2; ++k) dst[m][k] = *(const PG8_LAS bf16x8*)(lds + PG8_SA(b, h) + aoff + m * 2048 + k * 1024); } while (0)
#define PG8_LDB(dst, b, h) do { _Pragma("unroll") for (int n = 0; n < 2; ++n) _Pragma("unroll") for (int k = 0; k < 2; ++k) dst[n][k] = *(const PG8_LAS bf16x8*)(lds + PG8_SB(b, h) + boff + n * 2048 + k * 1024); } while (0)
#define PG8_MMA(ai, bj, At, Bt) do { __builtin_amdgcn_s_setprio(1); _Pragma("unroll") for (int m = 0; m < 4; ++m) _Pragma("unroll") for (int n = 0; n < 2; ++n) _Pragma("unroll") for (int k = 0; k < 2; ++k) \
        acc[ai][bj][m][n] = __builtin_amdgcn_mfma_f32_16x16x32_bf16(Bt[n][k], At[m][k], acc[ai][bj][m][n], 0, 0, 0); __builtin_amdgcn_s_setprio(0); } while (0)
#define PG8_WAIT_V(n) asm volatile("s_waitcnt vmcnt(" #n ")" ::: "memory")
#define PG8_WAIT_L(n) asm volatile("s_waitcnt lgkmcnt(" #n ")" ::: "memory")
#define PG8_BAR __builtin_amdgcn_s_barrier()
#define PG8_SCHED __builtin_amdgcn_sched_barrier(0)
    Unit cur, nxt; int ui = 0;
    if (!S.next(0, cur)) return;
    f32x4 acc[2][2][4][2];
#pragma unroll
    for (int a = 0; a < 2; ++a)
#pragma unroll
        for (int b = 0; b < 2; ++b)
#pragma unroll
            for (int m = 0; m < 4; ++m)
#pragma unroll
                for (int n = 0; n < 2; ++n) acc[a][b][m][n] = (f32x4){0.f, 0.f, 0.f, 0.f};
    bf16x8 At[4][2], B0[2][2], B1[2][2];
    const char* cA = (const char*)g.A + (size_t)cur.pm * tstep; const char* cB = (const char*)g.Bt + (size_t)cur.pn * tstep;
    S.a_ready(cur);
    if constexpr (SP2) {
        PG8_STAGE(PG8_SB(0, 0), cB, voffB); PG8_STAGE(PG8_SB(0, 1), cB + hstep, voffB); PG8_STAGE(PG8_SA(0, 0), cA, voffA); PG8_STAGE(PG8_SA(0, 1), cA + hstep, voffA);
        if (wr == 1) PG8_BAR;
        PG8_WAIT_V(2); PG8_BAR;
        PG8_STAGE(PG8_SB(1, 0), cB + kstep, voffB); PG8_STAGE(PG8_SA(1, 0), cA + kstep, voffA); PG8_STAGE(PG8_SB(1, 1), cB + hstep + kstep, voffB);
        PG8_WAIT_V(6); PG8_BAR;
    } else {
        PG8_STAGE(PG8_SB(0, 0), cB, voffB); PG8_STAGE(PG8_SA(0, 0), cA, voffA); PG8_STAGE(PG8_SB(0, 1), cB + hstep, voffB); PG8_STAGE(PG8_SA(0, 1), cA + hstep, voffA);
        if (wr == 1) PG8_BAR;
        PG8_WAIT_V(4); PG8_BAR;
        PG8_STAGE(PG8_SB(1, 0), cB + kstep, voffB); PG8_STAGE(PG8_SA(1, 0), cA + kstep, voffA); PG8_STAGE(PG8_SB(1, 1), cB + hstep + kstep, voffB);
        PG8_WAIT_V(6); PG8_BAR;
    }
    for (;;) {
        const bool has_next = S.next(ui + 1, nxt);
        const char* nA = has_next ? (const char*)g.A + (size_t)nxt.pm * tstep : cA; const char* nB = has_next ? (const char*)g.Bt + (size_t)nxt.pn * tstep : cB;
        for (int t = 0; t < nt; t += 2) {
            const bool last = (t == nt - 2);
            const char* a1 = cA + (size_t)(t + 1) * kstep;
            const char* a2 = last ? nA : cA + (size_t)(t + 2) * kstep; const char* b2 = last ? nB : cB + (size_t)(t + 2) * kstep;
            const char* a3 = a2 + kstep; const char* b3 = b2 + kstep;
            if (last && has_next) S.a_ready(nxt);
            if constexpr (SP2) {
            PG8_LDB(B0, 0, 0); PG8_LDB(B1, 0, 1); PG8_SCHED; PG8_LDA(At, 0, 0); PG8_STAGE(PG8_SA(1, 1), a1 + hstep, voffA);
            PG8_WAIT_V(8); PG8_WAIT_L(0); PG8_BAR; PG8_MMA(0, 0, At, B0); PG8_MMA(0, 1, At, B1); PG8_BAR; PG8_SCHED;
            PG8_LDA(At, 0, 1); PG8_STAGE(PG8_SB(0, 0), b2, voffB); PG8_STAGE(PG8_SB(0, 1), b2 + hstep, voffB); PG8_STAGE(PG8_SA(0, 0), a2, voffA);
            PG8_WAIT_V(8); PG8_WAIT_L(0); PG8_BAR; PG8_MMA(1, 0, At, B0); PG8_MMA(1, 1, At, B1); PG8_BAR; PG8_SCHED;
            PG8_LDB(B0, 1, 0); PG8_LDB(B1, 1, 1); PG8_SCHED; PG8_LDA(At, 1, 0); PG8_STAGE(PG8_SA(0, 1), a2 + hstep, voffA);
            PG8_WAIT_V(8); PG8_WAIT_L(0); PG8_BAR; PG8_MMA(0, 0, At, B0); PG8_MMA(0, 1, At, B1); PG8_BAR; PG8_SCHED;
            PG8_LDA(At, 1, 1); PG8_STAGE(PG8_SB(1, 0), b3, voffB); PG8_STAGE(PG8_SB(1, 1), b3 + hstep, voffB); PG8_STAGE(PG8_SA(1, 0), a3, voffA);
            PG8_WAIT_V(8); PG8_WAIT_L(0); PG8_BAR; PG8_MMA(1, 0, At, B0); PG8_MMA(1, 1, At, B1); PG8_BAR; PG8_SCHED;
            } else {
            PG8_LDB(B0, 0, 0); PG8_SCHED; PG8_LDA(At, 0, 0); PG8_STAGE(PG8_SA(1, 1), a1 + hstep, voffA);
            PG8_WAIT_L(8); PG8_BAR; PG8_WAIT_L(0); PG8_MMA(0, 0, At, B0); PG8_BAR; PG8_SCHED;
            PG8_LDB(B1, 0, 1); PG8_STAGE(PG8_SB(0, 0), b2, voffB);
            PG8_BAR; PG8_WAIT_L(0); PG8_MMA(0, 1, At, B1); PG8_BAR;
            PG8_LDA(At, 0, 1); PG8_STAGE(PG8_SA(0, 0), a2, voffA);
            PG8_BAR; PG8_WAIT_L(0); PG8_MMA(1, 0, At, B0); PG8_BAR; PG8_SCHED;
            PG8_STAGE(PG8_SB(0, 1), b2 + hstep, voffB);
            PG8_WAIT_V(6); PG8_BAR; PG8_MMA(1, 1, At, B1); PG8_BAR;
            PG8_LDB(B0, 1, 0); PG8_SCHED; PG8_LDA(At, 1, 0); PG8_STAGE(PG8_SA(0, 1), a2 + hstep, voffA);
            PG8_WAIT_L(8); PG8_BAR; PG8_WAIT_L(0); PG8_MMA(0, 0, At, B0); PG8_BAR; PG8_SCHED;
            PG8_LDB(B1, 1, 1); PG8_STAGE(PG8_SB(1, 0), b3, voffB);
            PG8_BAR; PG8_WAIT_L(0); PG8_MMA(0, 1, At, B1); PG8_BAR;
            PG8_LDA(At, 1, 1); PG8_STAGE(PG8_SA(1, 0), a3, voffA);
            PG8_BAR; PG8_WAIT_L(0); PG8_MMA(1, 0, At, B0); PG8_BAR; PG8_SCHED;
            PG8_STAGE(PG8_SB(1, 1), b3 + hstep, voffB);
            PG8_WAIT_V(6); PG8_BAR; PG8_MMA(1, 1, At, B1); PG8_BAR;
            }
        }
        if constexpr (ALIGN_EPI) { if (wr == 0) PG8_BAR; }
        if constexpr (!Epi::AFTER_DRAIN) { E(acc, cur, wr, wc, fr, fq); S.done(cur); }
        if (!has_next) break;
#pragma unroll
        for (int a = 0; a < 2; ++a)
#pragma unroll
            for (int b = 0; b < 2; ++b)
#pragma unroll
                for (int m = 0; m < 4; ++m)
#pragma unroll
                    for (int n = 0; n < 2; ++n) acc[a][b][m][n] = (f32x4){0.f, 0.f, 0.f, 0.f};
        cur = nxt; cA = nA; cB = nB; ++ui;
        if constexpr (ALIGN_EPI) { if (wr == 1) PG8_BAR; }
    }
    PG8_WAIT_V(0);
    if constexpr (!ALIGN_EPI) { if (wr == 0) PG8_BAR; }
    PG8_BAR;
    if constexpr (Epi::AFTER_DRAIN) { E.fused(acc, cur, wr, wc, fr, fq, lds, wid, lane); S.done(cur); }
#undef PG8_SA
#undef PG8_SB
#undef PG8_STAGE
#undef PG8_LDA
#undef PG8_LDB
#undef PG8_MMA
#undef PG8_WAIT_V
#undef PG8_WAIT_L
#undef PG8_BAR
#undef PG8_SCHED
}
}

#define LAS __attribute__((address_space(3)))
typedef unsigned short bf16;
typedef float f32x4 __attribute__((ext_vector_type(4)));
typedef unsigned v4u __attribute__((ext_vector_type(4)));
#define LDS_WAIT() asm volatile("s_waitcnt lgkmcnt(0)" ::: "memory")
#define XB_TMO      128
#define XB_XCNT(j)  (256  + 64 * (j))
#define XB_XSUB(j)  (1280 + 64 * (j))
#define XB_XGEN(j)  (2304 + 64 * (j))
#define XB_TOP      3328
#define XB_TOPGEN   3392
#define XCD_BAR_WORDS 3456
#define XB_SPIN_CAP (1u << 18)

__device__ __forceinline__ unsigned xb_ld(unsigned* p)              { return __hip_atomic_load(p, __ATOMIC_RELAXED, __HIP_MEMORY_SCOPE_AGENT); }
__device__ __forceinline__ unsigned xb_add(unsigned* p, unsigned v) { return __hip_atomic_fetch_add(p, v, __ATOMIC_RELAXED, __HIP_MEMORY_SCOPE_AGENT); }
__device__ __forceinline__ unsigned xb_xcc_id() { return (unsigned)__builtin_amdgcn_s_getreg((3 << 11) | 20) & 0xFu; }
#define XB_SPIN(cond, bar) do { unsigned _sp = 0; while (cond) { __builtin_amdgcn_s_sleep(1); \
    if ((++_sp & 255u) == 0u) { if (xb_ld(&(bar)[XB_TMO])) break; if (_sp > XB_SPIN_CAP) { atomicAdd(&(bar)[XB_TMO], 1u); break; } } } } while (0)

struct XcdBarrier {
    int w;
    unsigned* bar; unsigned x;
    volatile LAS unsigned* st;
};

__device__ __forceinline__ XcdBarrier xcd_barrier_post(unsigned* bar, volatile LAS unsigned* st) {
    XcdBarrier b; b.bar = bar; b.x = xb_xcc_id(); b.st = st;
    if (threadIdx.x == 0) (void)xb_add(&bar[XB_XCNT(b.x)], 1u);
    return b;
}
__device__ __forceinline__ void xcd_barrier_complete(unsigned* bar, unsigned x, unsigned& nloc, unsigned& nx) {
    const unsigned G = gridDim.x * gridDim.y * gridDim.z;
    unsigned sum, cnt, mine, sp = 0u;
    for (;;) {
        sum = 0u; cnt = 0u; mine = 0u;
#pragma unroll
        for (unsigned j = 0; j < 16; ++j) { const unsigned c = xb_ld(&bar[XB_XCNT(j)]); sum += c; cnt += (c > 0u) ? 1u : 0u; mine = (j == x) ? c : mine; }
        if (sum == G) break;
        __builtin_amdgcn_s_sleep(1);
        if ((++sp & 255u) == 0u) { if (xb_ld(&bar[XB_TMO])) break; if (sp > XB_SPIN_CAP) { atomicAdd(&bar[XB_TMO], 1u); break; } }
    }
    nloc = mine > 0u ? mine : 1u; nx = cnt > 0u ? cnt : 1u;
}

__device__ __forceinline__ void xcd_barrier(const XcdBarrier& b) {
    asm volatile("s_waitcnt vmcnt(0)" ::: "memory");
    __syncthreads();
    if (b.w == 0 && __builtin_amdgcn_mbcnt_hi(~0u, __builtin_amdgcn_mbcnt_lo(~0u, 0u)) == 0u) {
        unsigned* bar = b.bar;
        __builtin_amdgcn_s_waitcnt(0);
        unsigned nloc = b.st[0], nx = b.st[1];
        if (nloc == 0u) { xcd_barrier_complete(bar, b.x, nloc, nx); b.st[0] = nloc; b.st[1] = nx; }
        const unsigned old = xb_add(&bar[XB_XSUB(b.x)], 1u);
        const unsigned gen = old / nloc;
        if (old + 1u == (gen + 1u) * nloc) {
            __builtin_amdgcn_fence(__ATOMIC_RELEASE, "agent");
            asm volatile("s_waitcnt vmcnt(0)" ::: "memory");
            const unsigned og = xb_add(&bar[XB_TOP], 1u);
            const unsigned tg = og / nx;
            if (og + 1u == (tg + 1u) * nx) xb_add(&bar[XB_TOPGEN], 1u);
            else XB_SPIN(xb_ld(&bar[XB_TOPGEN]) == tg, bar);
            __builtin_amdgcn_fence(__ATOMIC_ACQUIRE, "agent");
            xb_add(&bar[XB_XGEN(b.x)], 1u);
            asm volatile("s_waitcnt vmcnt(0)" ::: "memory");
        } else {
            XB_SPIN(xb_ld(&bar[XB_XGEN(b.x)]) == gen, bar);
            __builtin_amdgcn_fence(__ATOMIC_ACQUIRE, "agent");
            asm volatile("s_waitcnt vmcnt(0)" ::: "memory");
        }
    }
    __syncthreads();
}

__device__ __forceinline__ int opaque_tid(int wave_s) { int t; asm volatile("v_mbcnt_lo_u32_b32 %0, -1, 0\n\tv_mbcnt_hi_u32_b32 %0, -1, %0" : "=v"(t)); return wave_s * 64 + t; }
__device__ __forceinline__ unsigned f2bf(float f) { unsigned u = __builtin_bit_cast(unsigned, f); return (u + 0x7fffu + ((u >> 16) & 1u)) >> 16; }
__device__ __forceinline__ unsigned pk2(float lo, float hi) { return f2bf(lo) | (f2bf(hi) << 16); }
__device__ __forceinline__ float bf2f(unsigned x) { return __uint_as_float(x << 16); }
__device__ __forceinline__ float wave_sum(float v) {
#pragma unroll
    for (int o = 1; o < 64; o <<= 1) v += __shfl_xor(v, o);
    return v;
}
__device__ __forceinline__ int t5_bucket(int rel) {
    const int ret = rel > 0 ? 16 : 0; const int n = rel < 0 ? -rel : rel;
    if (n < 8) return ret + n;
    const int v = (n * n) >> 6; int lg = 31 - __clz(v); int large = 8 + lg; if (large > 15) large = 15;
    return ret + large;
}
__device__ __forceinline__ int in_dst_row(int n) {
    if (n < 1536 || n >= 3584) return n;
    const int base = n < 2560 ? 1536 : 2560, rel = n - base, dd = rel & 127;
    return base + (rel & ~127) + (dd < 64 ? 2 * dd : 2 * (dd - 64) + 1);
}
__device__ __forceinline__ void conv_item(const float* W, int K, int N, bf16* WT, LAS float* scr, int item, int lane, bool perm_in, const float* gain) {
    const int nblk = N / 64, kb = item / nblk, nb = item % nblk, k0 = 32 * kb, n0 = 64 * nb;
    const int c4 = lane & 15, kq = lane >> 4;
    f32x4 v[8];
#pragma unroll
    for (int i = 0; i < 8; ++i) v[i] = *(const f32x4*)(W + (size_t)(k0 + 4 * i + kq) * N + n0 + c4 * 4);
    if (gain) {
#pragma unroll
        for (int i = 0; i < 8; ++i) v[i] = v[i] * gain[k0 + 4 * i + kq]; }
#pragma unroll
    for (int i = 0; i < 8; ++i) *(LAS f32x4*)(scr + (4 * i + kq) * 68 + c4 * 4) = v[i];
    LDS_WAIT(); asm volatile("" ::: "memory");
    const int dst = perm_in ? in_dst_row(n0 + lane) : n0 + lane;
    bf16* op = WT + (size_t)dst * K + k0;
#pragma unroll
    for (int q = 0; q < 4; ++q) { const LAS float* sp = scr + (8 * q) * 68 + lane;
        v4u o; o.x = pk2(sp[0 * 68], sp[1 * 68]); o.y = pk2(sp[2 * 68], sp[3 * 68]); o.z = pk2(sp[4 * 68], sp[5 * 68]); o.w = pk2(sp[6 * 68], sp[7 * 68]);
        *(v4u*)(op + 8 * q) = o; }
    LDS_WAIT(); asm volatile("" ::: "memory");
}
__device__ __forceinline__ void x_row_init(const float* xrow, bf16* yrow, float* hcopy, float* ss, int lane) {
    const f32x4* xr = (const f32x4*)xrow + lane; f32x4 v[8]; float s = 0.f;
#pragma unroll
    for (int j = 0; j < 8; ++j) { v[j] = xr[64 * j]; s += (v[j].x * v[j].x + v[j].y * v[j].y) + (v[j].z * v[j].z + v[j].w * v[j].w); }
    s = wave_sum(s);
    f32x4* hr = (f32x4*)hcopy + lane; uint2* yr = (uint2*)yrow + lane;
#pragma unroll
    for (int j = 0; j < 8; ++j) { hr[64 * j] = v[j]; uint2 w; w.x = pk2(v[j].x, v[j].y); w.y = pk2(v[j].z, v[j].w); yr[64 * j] = w; }
    if (lane == 0) *ss = s;
}
__device__ __forceinline__ void ph_final_norm(const Params& P, int wave_s) {
    const float* H = (const float*)(P.ws + WS_H); const float* ss = (const float*)(P.ws + WS_CTL + CTL_SS) + 6 * M;
    const int tid = opaque_tid(wave_s); const int lane = tid & 63, gw = blockIdx.x * 8 + (tid >> 6), ngw = gridDim.x * 8;
    for (int r = gw; r < M; r += ngw) {
        const f32x4* xr = (const f32x4*)(H + (size_t)r * D) + lane;
        const float rs = rsqrtf(__hip_atomic_load(ss + r, __ATOMIC_RELAXED, __HIP_MEMORY_SCOPE_AGENT) * (1.f / D) + EPS);
        f32x4* yr = (f32x4*)(P.out + OFF_Y + (size_t)r * D) + lane; const f32x4* gr = (const f32x4*)P.norm_final + lane;
#pragma unroll
        for (int j = 0; j < 8; ++j) yr[64 * j] = xr[64 * j] * rs * gr[64 * j];
    }
}
__device__ __forceinline__ void ph_prologue(const Params& P, LAS unsigned char* lds, int wave_s) {
    const int tid = opaque_tid(wave_s), lane = tid & 63, wave = tid >> 6;
    const int gw = blockIdx.x * 8 + wave, ngw = gridDim.x * 8;
    LAS float* scr = (LAS float*)(lds + wave * 16384);
    constexpr int I_IN = 64 * 88, I_OUT = 64 * 32, I_UP = 64 * 128, I_DOWN = 256 * 32, I_GATE = 64 * 32, I_PLE = 8 * 32, I_L = I_IN + I_OUT + I_UP + I_DOWN + I_GATE + I_PLE;
    for (int it = gw; it < 2 * I_L; it += ngw) {
        const int l = it / I_L; int r = it % I_L; unsigned char* wl = P.ws + WS_W + (size_t)l * WL_STRIDE;
        if (r < I_IN) { conv_item(P.w_in + (size_t)l * D * INW, D, INW, (bf16*)(wl + WL_IN), scr, r, lane, true, P.norm_mix + l * D); continue; } r -= I_IN;
        if (r < I_OUT) { conv_item(P.w_out + (size_t)l * D * D, D, D, (bf16*)(wl + WL_OUT), scr, r, lane, false, nullptr); continue; } r -= I_OUT;
        if (r < I_UP) { conv_item(P.w_up + (size_t)l * D * FFW, D, FFW, (bf16*)(wl + WL_UP), scr, r, lane, false, P.norm_mlp + l * D); continue; } r -= I_UP;
        if (r < I_DOWN) { conv_item(P.w_down + (size_t)l * FFW * D, FFW, D, (bf16*)(wl + WL_DOWN), scr, r, lane, false, nullptr); continue; } r -= I_DOWN;
        if (r < I_GATE) { conv_item(P.w_gate + (size_t)l * D * D, D, D, (bf16*)(wl + WL_GATE), scr, r, lane, false, P.norm_ple + l * D); continue; } r -= I_GATE;
        conv_item(P.w_ple + (size_t)l * PLE * D, PLE, D, (bf16*)(wl + WL_PLE), scr, r, lane, false, nullptr);
    }
    float* H = (float*)(P.ws + WS_H); bf16* HB2 = (bf16*)(P.ws + WS_HB2); float* ss0 = (float*)(P.ws + WS_CTL + CTL_SS);
    for (int r = gw; r < M; r += ngw) {
        const float* xrow = r < SEQ ? P.x_prompt + (size_t)r * D : P.x_sample + (size_t)(r - SEQ) * D;
        x_row_init(xrow, HB2 + (size_t)r * D, H + (size_t)r * D, ss0 + r, lane);
    }
    const size_t gt = (size_t)blockIdx.x * 512 + tid, gs = (size_t)gridDim.x * 512;
    bf16* PBB = (bf16*)(P.ws + WS_PBB);
    for (size_t i = gt; i < (size_t)2 * M * PLE / 4; i += gs) {
        const size_t e = i * 4; const int l = (int)(e / ((size_t)M * PLE)); const size_t r = e % ((size_t)M * PLE); f32x4 v;
        if (r < (size_t)SEQ * PLE) v = *(const f32x4*)(P.p_prompt + (size_t)l * SEQ * PLE + r); else v = *(const f32x4*)(P.p_sample + (size_t)l * NSAMP * PLE + (r - (size_t)SEQ * PLE));
        uint2 w; w.x = pk2(v.x, v.y); w.y = pk2(v.z, v.w); *(uint2*)(PBB + e) = w;
    }
    float* CS = (float*)(P.ws + WS_CS);
    for (size_t i = gt; i < (size_t)SEQ * 64; i += gs) {
        const int pos = (int)(i >> 6), d = (int)(i & 63);
        const double inv = pow(10000.0, -(double)d / 64.0); const double ang = (double)pos * inv;
        CS[2 * i] = (float)cos(ang); CS[2 * i + 1] = (float)sin(ang);
    }
}

__device__ __forceinline__ void ld16_bf16(const bf16* p, f32x4 (&o)[4]) {
    const v4u a = *(const v4u*)p, b = *(const v4u*)(p + 8);
    o[0] = (f32x4){bf2f(a.x & 0xffffu), bf2f(a.x >> 16), bf2f(a.y & 0xffffu), bf2f(a.y >> 16)}; o[1] = (f32x4){bf2f(a.z & 0xffffu), bf2f(a.z >> 16), bf2f(a.w & 0xffffu), bf2f(a.w >> 16)};
    o[2] = (f32x4){bf2f(b.x & 0xffffu), bf2f(b.x >> 16), bf2f(b.y & 0xffffu), bf2f(b.y >> 16)}; o[3] = (f32x4){bf2f(b.z & 0xffffu), bf2f(b.z >> 16), bf2f(b.w & 0xffffu), bf2f(b.w >> 16)};
}
__device__ __forceinline__ void ld16_f32(const float* p, f32x4 (&o)[4]) {
#pragma unroll
    for (int j = 0; j < 4; ++j) o[j] = *(const f32x4*)(p + 4 * j);
}
typedef short bf16x8 __attribute__((ext_vector_type(8)));
__device__ __forceinline__ f32x4 mma_blk(const LAS bf16* F, int ldf, const LAS bf16* S, int lds_, int kd, f32x4 acc, int fr, int fq) {
    for (int k = 0; k < kd; k += 32) {
        const bf16x8 a = *(const LAS bf16x8*)(F + fr * ldf + k + fq * 8);
        const bf16x8 b = *(const LAS bf16x8*)(S + fr * lds_ + k + fq * 8);
        acc = __builtin_amdgcn_mfma_f32_16x16x32_bf16(a, b, acc, 0, 0, 0);
    }
    return acc;
}
__device__ __forceinline__ float grp16_max(float v) { v = fmaxf(v, __shfl_xor(v, 1)); v = fmaxf(v, __shfl_xor(v, 2)); v = fmaxf(v, __shfl_xor(v, 4)); v = fmaxf(v, __shfl_xor(v, 8)); return v; }
__device__ __forceinline__ float grp16_sum(float v) { v += __shfl_xor(v, 1); v += __shfl_xor(v, 2); v += __shfl_xor(v, 4); v += __shfl_xor(v, 8); return v; }

template <bool SAMPLE> __device__ __forceinline__ void attn_unit(const Params& P, int l, int cb, int kh, LAS unsigned char* lds, int tid) {
    constexpr int NKB = SAMPLE ? 10 : 12, NK = NKB * 16, QMASK = SAMPLE ? 15 : 63, QSH = SAMPLE ? 4 : 6;
    const bf16* PROJ = (const bf16*)(P.ws + WS_BIG); bf16* MIXB = (bf16*)(P.ws + WS_MIXB);
    LAS bf16* Ks = (LAS bf16*)lds;
    LAS bf16* Vt = (LAS bf16*)(lds + 27648);
    LAS bf16* Pw = (LAS bf16*)(lds + 53248);
    LAS float* LUT = (LAS float*)(lds + 104448);
    const int lane = tid & 63, w = tid >> 6, fr = lane & 15, fq = lane >> 4;
    const v4u zero4 = (v4u){0u, 0u, 0u, 0u};
    const int tok0 = SAMPLE ? SEQ + cb * 16 : cb * 64;
    if (!SAMPLE) {
#pragma unroll
        for (int i = 0; i < 3; ++i) { const int idx = tid + i * 512, key = idx >> 3, ch = idx & 7; const int kpos = cb * 64 - 128 + key;
            v4u v = zero4; if (kpos >= 0) v = *(const v4u*)(PROJ + (size_t)kpos * INW + 1024 + kh * 64 + ch * 8);
            *(LAS v4u*)(Ks + key * 72 + ch * 8) = v; }
#pragma unroll
        for (int grp = 0; grp < 3; ++grp) { const int key = grp * 64 + lane, kpos = cb * 64 - 128 + key;
            v4u v = zero4; if (kpos >= 0) v = *(const v4u*)(PROJ + (size_t)kpos * INW + 1280 + kh * 64 + w * 8);
            LAS bf16* d = Vt + (w * 8) * 200 + key;
            d[0 * 200] = (bf16)(v.x & 0xffffu); d[1 * 200] = (bf16)(v.x >> 16); d[2 * 200] = (bf16)(v.y & 0xffffu); d[3 * 200] = (bf16)(v.y >> 16);
            d[4 * 200] = (bf16)(v.z & 0xffffu); d[5 * 200] = (bf16)(v.z >> 16); d[6 * 200] = (bf16)(v.w & 0xffffu); d[7 * 200] = (bf16)(v.w >> 16); }
    } else {
        const float* ck = P.cache_k + (((size_t)l * DEC_B + cb) * 128) * 256 + kh * 64; const float* cv = P.cache_v + (((size_t)l * DEC_B + cb) * 128) * 256 + kh * 64;
#pragma unroll
        for (int i = 0; i < 2; ++i) { const int idx = tid + i * 512, key = idx >> 3, ch = idx & 7; const float* p = ck + (size_t)key * 256 + ch * 8;
            const f32x4 a = *(const f32x4*)p, b = *(const f32x4*)(p + 4); v4u v; v.x = pk2(a.x, a.y); v.y = pk2(a.z, a.w); v.z = pk2(b.x, b.y); v.w = pk2(b.z, b.w);
            *(LAS v4u*)(Ks + key * 72 + ch * 8) = v; }
        if (tid < 256) { const int key = 128 + (tid >> 3), ch = tid & 7; v4u v = zero4; if (key < 144) v = *(const v4u*)(PROJ + (size_t)(tok0 + key - 128) * INW + 1024 + kh * 64 + ch * 8);
            *(LAS v4u*)(Ks + key * 72 + ch * 8) = v; }
#pragma unroll
        for (int grp = 0; grp < 2; ++grp) { const int key = grp * 64 + lane; const float* p = cv + (size_t)key * 256 + w * 8; const f32x4 a = *(const f32x4*)p, b = *(const f32x4*)(p + 4);
            LAS bf16* d = Vt + (w * 8) * 200 + key;
            d[0 * 200] = (bf16)f2bf(a.x); d[1 * 200] = (bf16)f2bf(a.y); d[2 * 200] = (bf16)f2bf(a.z); d[3 * 200] = (bf16)f2bf(a.w);
            d[4 * 200] = (bf16)f2bf(b.x); d[5 * 200] = (bf16)f2bf(b.y); d[6 * 200] = (bf16)f2bf(b.z); d[7 * 200] = (bf16)f2bf(b.w); }
        if (lane < 32) { const int key = 128 + lane; v4u v = zero4; if (lane < 16) v = *(const v4u*)(PROJ + (size_t)(tok0 + lane) * INW + 1280 + kh * 64 + w * 8);
            LAS bf16* d = Vt + (w * 8) * 200 + key;
            d[0 * 200] = (bf16)(v.x & 0xffffu); d[1 * 200] = (bf16)(v.x >> 16); d[2 * 200] = (bf16)(v.y & 0xffffu); d[3 * 200] = (bf16)(v.y >> 16);
            d[4 * 200] = (bf16)(v.z & 0xffffu); d[5 * 200] = (bf16)(v.z >> 16); d[6 * 200] = (bf16)(v.w & 0xffffu); d[7 * 200] = (bf16)(v.w >> 16); }
    }
    for (int t = tid; t < 1020; t += 512) { const int g = t / 255, idx = t % 255; LUT[g * 256 + idx] = P.rel_bias[t5_bucket(idx - 191) * 16 + kh * 4 + g]; }
    __syncthreads();
    const int npass = SAMPLE ? (w < 4 ? 1 : 0) : 2;
#pragma unroll 1
    for (int pass = 0; pass < npass; ++pass) {
        const int r0 = SAMPLE ? w * 16 : (2 * w + pass) * 16, g = r0 >> QSH, hq = kh * 4 + g; const float sink = P.attn_sink[l * 16 + hq];
        bf16x8 qf[2];
        { const int q = (r0 + fr) & QMASK; const bf16* qp = PROJ + (size_t)(tok0 + q) * INW + hq * 64 + fq * 8; qf[0] = *(const bf16x8*)qp; qf[1] = *(const bf16x8*)(qp + 32); }
        f32x4 acc[NKB];
#pragma unroll
        for (int kb = 0; kb < NKB; ++kb) { acc[kb] = (f32x4){0.f, 0.f, 0.f, 0.f};
#pragma unroll
            for (int ks = 0; ks < 2; ++ks) { const bf16x8 b = *(const LAS bf16x8*)(Ks + (kb * 16 + fr) * 72 + ks * 32 + fq * 8); acc[kb] = __builtin_amdgcn_mfma_f32_16x16x32_bf16(qf[ks], b, acc[kb], 0, 0, 0); } }
        LAS bf16* pw = Pw + w * (16 * 200);
#pragma unroll
        for (int reg = 0; reg < 4; ++reg) {
            const int q = (r0 + fq * 4 + reg) & QMASK; float mx = -INFINITY;
#pragma unroll
            for (int kb = 0; kb < NKB; ++kb) { const int key = kb * 16 + fr; float s = acc[kb][reg] * 0.125f + LUT[g * 256 + key - q + 63];
                if (SAMPLE ? (key >= 144) : (cb * 64 - 128 + key < 0)) s = -INFINITY; acc[kb][reg] = s; mx = fmaxf(mx, s); }
            const float m = fmaxf(grp16_max(mx), sink); float sum = 0.f;
#pragma unroll
            for (int kb = 0; kb < NKB; ++kb) { const float p = __expf(acc[kb][reg] - m); acc[kb][reg] = p; sum += p; }
            const float inv = 1.f / (grp16_sum(sum) + __expf(sink - m));
#pragma unroll
            for (int kb = 0; kb < NKB; ++kb) pw[(fq * 4 + reg) * 200 + kb * 16 + fr] = (bf16)f2bf(acc[kb][reg] * inv);
        }
        LDS_WAIT(); asm volatile("" ::: "memory");
        f32x4 o[4];
#pragma unroll
        for (int db = 0; db < 4; ++db) o[db] = mma_blk(Vt + db * 16 * 200, 200, pw, 200, NK, (f32x4){0.f, 0.f, 0.f, 0.f}, fr, fq);
        { const int q = (r0 + fr) & QMASK; bf16* op = MIXB + (size_t)(tok0 + q) * D + hq * 64 + fq * 4;
#pragma unroll
            for (int db = 0; db < 4; ++db) { uint2 wv; wv.x = pk2(o[db][0], o[db][1]); wv.y = pk2(o[db][2], o[db][3]); *(uint2*)(op + db * 16) = wv; } }
        LDS_WAIT(); asm volatile("" ::: "memory");
    }
    __syncthreads();
}

__device__ __forceinline__ void ret_upd_unit(const Params& P, int c, int h, LAS unsigned char* lds, int tid) {
    const bf16* PROJ = (const bf16*)(P.ws + WS_BIG); bf16* UPDt = (bf16*)(P.ws + WS_UPD);
    LAS bf16* Kt = (LAS bf16*)lds;
    LAS bf16* Vzt = (LAS bf16*)(lds + 18432);
    const int lane = tid & 63, w = tid >> 6, fr = lane & 15, fq = lane >> 4;
    const float lg2 = log2f(1.f - exp2f(-5.f - (float)h));
    const float zeta = exp2f((float)(63 - lane) * lg2);
    const bf16* rowp = PROJ + (size_t)(c * 64 + lane) * INW + h * 128;
#pragma unroll
    for (int i = 0; i < 2; ++i) { const int cc = w + 8 * i;
        const v4u kv = *(const v4u*)(rowp + 2560 + cc * 8), vv = *(const v4u*)(rowp + 3584 + cc * 8);
        LAS bf16* dk = Kt + (cc * 8) * 72 + lane; LAS bf16* dv = Vzt + (cc * 8) * 72 + lane;
        dk[0 * 72] = (bf16)(kv.x & 0xffffu); dk[1 * 72] = (bf16)(kv.x >> 16); dk[2 * 72] = (bf16)(kv.y & 0xffffu); dk[3 * 72] = (bf16)(kv.y >> 16);
        dk[4 * 72] = (bf16)(kv.z & 0xffffu); dk[5 * 72] = (bf16)(kv.z >> 16); dk[6 * 72] = (bf16)(kv.w & 0xffffu); dk[7 * 72] = (bf16)(kv.w >> 16);
        dv[0 * 72] = (bf16)f2bf(bf2f(vv.x & 0xffffu) * zeta); dv[1 * 72] = (bf16)f2bf(bf2f(vv.x >> 16) * zeta); dv[2 * 72] = (bf16)f2bf(bf2f(vv.y & 0xffffu) * zeta); dv[3 * 72] = (bf16)f2bf(bf2f(vv.y >> 16) * zeta);
        dv[4 * 72] = (bf16)f2bf(bf2f(vv.z & 0xffffu) * zeta); dv[5 * 72] = (bf16)f2bf(bf2f(vv.z >> 16) * zeta); dv[6 * 72] = (bf16)f2bf(bf2f(vv.w & 0xffffu) * zeta); dv[7 * 72] = (bf16)f2bf(bf2f(vv.w >> 16) * zeta); }
    __syncthreads();
    bf16* up = UPDt + ((size_t)(c * 8 + h) * 128) * 128;
#pragma unroll
    for (int eb = 0; eb < 8; ++eb) {
        const f32x4 a = mma_blk(Kt + (w * 16) * 72, 72, Vzt + (eb * 16) * 72, 72, 64, (f32x4){0.f, 0.f, 0.f, 0.f}, fr, fq);
        uint2 wv; wv.x = pk2(a[0], a[1]); wv.y = pk2(a[2], a[3]);
        *(uint2*)(up + (size_t)(eb * 16 + fr) * 128 + w * 16 + fq * 4) = wv;
    }
    __syncthreads();
}
__device__ __forceinline__ void ph_ret_scan(const Params& P, int l, int wave_s) {
    const bf16* UPDt = (const bf16*)(P.ws + WS_UPD); bf16* SprevT = (bf16*)(P.ws + WS_UB);
    const int tid = opaque_tid(wave_s);
    for (int pr = blockIdx.x * 512 + tid; pr < 8 * 128 * 64; pr += gridDim.x * 512) {
        const int h = pr >> 13, e = (pr >> 6) & 127, s2 = (pr & 63) * 2;
        const float g64 = exp2f(64.f * log2f(1.f - exp2f(-5.f - (float)h)));
        const size_t off = ((size_t)h * 128 + e) * 128 + s2; const size_t cstride = (size_t)8 * 128 * 128;
        float s0 = 0.f, s1 = 0.f;
#pragma unroll 1
        for (int c0 = 0; c0 < 128; c0 += 8) {
            unsigned u[8];
#pragma unroll
            for (int k = 0; k < 8; ++k) u[k] = *(const unsigned*)(UPDt + off + (size_t)(c0 + k) * cstride);
#pragma unroll
            for (int k = 0; k < 8; ++k) { *(unsigned*)(SprevT + off + (size_t)(c0 + k) * cstride) = pk2(s0, s1); s0 = g64 * s0 + bf2f(u[k] & 0xffffu); s1 = g64 * s1 + bf2f(u[k] >> 16); }
        }
        float* so = P.out + OFF_NSP + ((size_t)l * 8 + h) * 16384;
        { const int od0 = (s2 >> 1), od1 = (s2 >> 1) + 64; so[od0 * 128 + e] = s0; so[od1 * 128 + e] = s1; }
    }
}
__device__ __forceinline__ void ret_out_unit(const Params& P, int l, int c, int h, LAS unsigned char* lds, int tid) {
    const bf16* PROJ = (const bf16*)(P.ws + WS_BIG); const bf16* SprevT = (const bf16*)(P.ws + WS_UB); bf16* MIXB = (bf16*)(P.ws + WS_MIXB);
    LAS bf16* Qs = (LAS bf16*)lds;
    LAS bf16* Ks = (LAS bf16*)(lds + 17408);
    LAS bf16* Vt = (LAS bf16*)(lds + 34816);
    LAS bf16* St = (LAS bf16*)(lds + 53248);
    LAS bf16* Pm = (LAS bf16*)(lds + 88064);
    LAS float* Of = (LAS float*)(lds + 97280);
    const int lane = tid & 63, w = tid >> 6, fr = lane & 15, fq = lane >> 4;
    const float lg2 = log2f(1.f - exp2f(-5.f - (float)h));
#pragma unroll
    for (int i = 0; i < 2; ++i) { const int idx = tid + i * 512, r = idx >> 4, ch = idx & 15; const bf16* rp = PROJ + (size_t)(c * 64 + r) * INW + h * 128 + ch * 8;
        *(LAS v4u*)(Qs + r * 136 + ch * 8) = *(const v4u*)(rp + 1536); *(LAS v4u*)(Ks + r * 136 + ch * 8) = *(const v4u*)(rp + 2560); }
    { const bf16* sp = SprevT + ((size_t)(c * 8 + h) * 128) * 128;
#pragma unroll
      for (int i = 0; i < 4; ++i) { const int idx = tid + i * 512, e = idx >> 4, ch = idx & 15; *(LAS v4u*)(St + e * 136 + ch * 8) = *(const v4u*)(sp + (size_t)e * 128 + ch * 8); } }
    { const bf16* rowp = PROJ + (size_t)(c * 64 + lane) * INW + 3584 + h * 128;
#pragma unroll
      for (int i = 0; i < 2; ++i) { const int cc = w + 8 * i; const v4u vv = *(const v4u*)(rowp + cc * 8); LAS bf16* dv = Vt + (cc * 8) * 72 + lane;
        dv[0 * 72] = (bf16)(vv.x & 0xffffu); dv[1 * 72] = (bf16)(vv.x >> 16); dv[2 * 72] = (bf16)(vv.y & 0xffffu); dv[3 * 72] = (bf16)(vv.y >> 16);
        dv[4 * 72] = (bf16)(vv.z & 0xffffu); dv[5 * 72] = (bf16)(vv.z >> 16); dv[6 * 72] = (bf16)(vv.w & 0xffffu); dv[7 * 72] = (bf16)(vv.w >> 16); } }
    __syncthreads();
    const int ib = w >> 1;
#pragma unroll
    for (int jj = 0; jj < 2; ++jj) { const int jb = (w & 1) * 2 + jj;
        const f32x4 a = mma_blk(Qs + (ib * 16) * 136, 136, Ks + (jb * 16) * 136, 136, 128, (f32x4){0.f, 0.f, 0.f, 0.f}, fr, fq);
#pragma unroll
        for (int reg = 0; reg < 4; ++reg) { const int i = ib * 16 + fq * 4 + reg, j = jb * 16 + fr; const float v = i >= j ? a[reg] * exp2f((float)(i - j) * lg2) : 0.f; Pm[i * 72 + j] = (bf16)f2bf(v); } }
    __syncthreads();
#pragma unroll
    for (int ee = 0; ee < 4; ++ee) { const int eb = (w & 1) * 4 + ee;
        const f32x4 pv = mma_blk(Pm + (ib * 16) * 72, 72, Vt + (eb * 16) * 72, 72, 64, (f32x4){0.f, 0.f, 0.f, 0.f}, fr, fq);
        const f32x4 x = mma_blk(Qs + (ib * 16) * 136, 136, St + (eb * 16) * 136, 136, 128, (f32x4){0.f, 0.f, 0.f, 0.f}, fr, fq);
#pragma unroll
        for (int reg = 0; reg < 4; ++reg) { const int i = ib * 16 + fq * 4 + reg; Of[i * 132 + eb * 16 + fr] = pv[reg] + exp2f((float)(i + 1) * lg2) * x[reg]; } }
    __syncthreads();
    { const int i = tid >> 3, e0 = (tid & 7) * 16; f32x4 v[4]; float ss = 0.f;
#pragma unroll
      for (int k = 0; k < 4; ++k) { v[k] = *(const LAS f32x4*)(Of + i * 132 + e0 + 4 * k); ss += (v[k].x * v[k].x + v[k].y * v[k].y) + (v[k].z * v[k].z + v[k].w * v[k].w); }
      ss += __shfl_xor(ss, 1); ss += __shfl_xor(ss, 2); ss += __shfl_xor(ss, 4);
      const float rs = rsqrtf(ss * (1.f / 128.f) + EPS);
      f32x4 gt[4]; ld16_bf16(PROJ + (size_t)(c * 64 + i) * INW + 4608 + h * 128 + e0, gt);
      const float* gn = P.ret_gain + l * 1024 + h * 128 + e0; v4u w0, w1; f32x4 r[4];
#pragma unroll
      for (int k = 0; k < 4; ++k) { const f32x4 gg = *(const f32x4*)(gn + 4 * k); r[k] = gt[k] * (v[k] * rs * gg); }
      w0.x = pk2(r[0].x, r[0].y); w0.y = pk2(r[0].z, r[0].w); w0.z = pk2(r[1].x, r[1].y); w0.w = pk2(r[1].z, r[1].w);
      w1.x = pk2(r[2].x, r[2].y); w1.y = pk2(r[2].z, r[2].w); w1.z = pk2(r[3].x, r[3].y); w1.w = pk2(r[3].z, r[3].w);
      bf16* op = MIXB + (size_t)(c * 64 + i) * D + 1024 + h * 128 + e0; *(v4u*)op = w0; *(v4u*)(op + 8) = w1; }
    __syncthreads();
}
__device__ __forceinline__ void ret_sample_item(const Params& P, int l, int b, int h, LAS unsigned char* lds, int tid) {
    const bf16* PROJ = (const bf16*)(P.ws + WS_BIG); bf16* MIXB = (bf16*)(P.ws + WS_MIXB);
    LAS float* sq = (LAS float*)lds; LAS float* sk = sq + 16 * 128; LAS float* so = sk + 16 * 128;
    const int row0 = SEQ + b * 16;
    const float gamma = 1.f - exp2f(-5.f - (float)h);
    float S[64]; const int e = tid & 127, half = (tid >> 7) & 1;
    const float* s0 = P.state_ret + (((size_t)l * DEC_B + b) * 8 + h) * 16384;
#pragma unroll
    for (int d = 0; d < 64; ++d) { const int s = half * 64 + d, od = (s >> 1) + 64 * (s & 1); S[d] = s0[od * 128 + e]; }
    for (int i = tid; i < 4096; i += 512) { const int tt = i >> 8, dd = i & 255, which = dd >> 7, d = dd & 127;
        const float v = bf2f(PROJ[(size_t)(row0 + tt) * INW + (which ? 2560 : 1536) + h * 128 + d]); (which ? sk : sq)[tt * 128 + d] = v; }
    __syncthreads();
    if (tid < 256) {
#pragma unroll 1
        for (int tt = 0; tt < 16; ++tt) {
            const float v = bf2f(PROJ[(size_t)(row0 + tt) * INW + 3584 + h * 128 + e]); float o = 0.f;
#pragma unroll
            for (int d = 0; d < 64; ++d) { S[d] = gamma * S[d] + sk[tt * 128 + half * 64 + d] * v; o += sq[tt * 128 + half * 64 + d] * S[d]; }
            so[(tt * 2 + half) * 128 + e] = o;
        }
        float* sp = P.out + OFF_NSS + (((size_t)l * DEC_B + b) * 8 + h) * 16384;
#pragma unroll
        for (int d = 0; d < 64; ++d) { const int s = half * 64 + d, od = (s >> 1) + 64 * (s & 1); sp[od * 128 + e] = S[d]; }
    }
    __syncthreads();
    { const int tt = tid >> 5, e0 = (tid & 31) * 4; float o[4]; float ss = 0.f;
#pragma unroll
      for (int k = 0; k < 4; ++k) { o[k] = so[(tt * 2) * 128 + e0 + k] + so[(tt * 2 + 1) * 128 + e0 + k]; ss += o[k] * o[k]; }
      ss += __shfl_xor(ss, 1); ss += __shfl_xor(ss, 2); ss += __shfl_xor(ss, 4); ss += __shfl_xor(ss, 8); ss += __shfl_xor(ss, 16);
      const float rs = rsqrtf(ss * (1.f / 128.f) + EPS);
      const bf16* gp = PROJ + (size_t)(row0 + tt) * INW + 4608 + h * 128 + e0; const float* gn = P.ret_gain + l * 1024 + h * 128 + e0;
      uint2 wv; wv.x = pk2(bf2f(gp[0]) * (o[0] * rs * gn[0]), bf2f(gp[1]) * (o[1] * rs * gn[1])); wv.y = pk2(bf2f(gp[2]) * (o[2] * rs * gn[2]), bf2f(gp[3]) * (o[3] * rs * gn[3]));
      *(uint2*)(MIXB + (size_t)(row0 + tt) * D + 1024 + h * 128 + e0) = wv; }
    __syncthreads();
}
__device__ __forceinline__ void ph_mix1(const Params& P, int l, LAS unsigned char* lds, int wave_s) {
    const int tid = opaque_tid(wave_s);
    const int G = gridDim.x, bx = blockIdx.x;
    for (int u = bx; u < 512; u += G) attn_unit<false>(P, l, u >> 2, u & 3, lds, tid);
    for (int u = G - 1 - bx; u < 128; u += G) attn_unit<true>(P, l, u >> 2, u & 3, lds, tid);
    for (int u = bx; u < 1024; u += G) ret_upd_unit(P, u >> 3, u & 7, lds, tid);
    for (int u = bx; u < 256; u += G) ret_sample_item(P, l, u >> 3, u & 7, lds, tid);
}
__device__ __forceinline__ void ph_mix3(const Params& P, int l, LAS unsigned char* lds, int wave_s) {
    const int tid = opaque_tid(wave_s);
    for (int u = blockIdx.x; u < 1024; u += gridDim.x) ret_out_unit(P, l, u >> 3, u & 7, lds, tid);
}
#define GEMM_PHASE(EPI) pg8::gemm_phase<EPI, pg8::StaticOrder, true, true>(lds, g, S, E, wave_s)
#define GRID_BAR() xcd_barrier(bar)
#ifndef REP_PRO
#define REP_PRO 1
#endif
#ifndef REP_INPROJ
#define REP_INPROJ 1
#endif
#ifndef REP_MIX
#define REP_MIX 1
#endif
#ifndef REP_UP
#define REP_UP 1
#endif
#ifndef REP_SATT
#define REP_SATT 1
#endif
#ifndef REP_SCAN
#define REP_SCAN 1
#endif
#ifndef REP_MIX3
#define REP_MIX3 1
#endif
template <int l> __device__ __forceinline__ void layer_body(const Params& P, LAS unsigned char* lds, const XcdBarrier& bar, int wave_s) {
    const int G = gridDim.x, bx = blockIdx.x;
    float* H = (float*)(P.ws + WS_H); bf16* HBa = (bf16*)(P.ws + WS_UB); bf16* HBb = (bf16*)(P.ws + WS_HB2); bf16* MIXB = (bf16*)(P.ws + WS_MIXB);
    bf16* PROJB = (bf16*)(P.ws + WS_BIG); bf16* FFB = (bf16*)(P.ws + WS_BIG); float* PL = (float*)(P.ws + WS_BIG); bf16* PBB = (bf16*)(P.ws + WS_PBB);
    const float* CS = (const float*)(P.ws + WS_CS); float* SS = (float*)(P.ws + WS_CTL + CTL_SS);
    const unsigned char* wl = P.ws + WS_W + (size_t)l * WL_STRIDE;
#pragma unroll
    for (int rep = 0; rep < REP_INPROJ; ++rep) {
    { pg8::Gemm g{HBb, (const bf16*)(wl + WL_IN), M, INW, D}; pg8::StaticOrder S; S.init(M, INW, G, bx); pg8::EpiProj E{PROJB, CS, P.out, l, SS + (3 * l) * M}; GEMM_PHASE(pg8::EpiProj); }
    GRID_BAR(); }
#pragma unroll
    for (int rep = 0; rep < REP_MIX; ++rep) {
    ph_mix1(P, l, lds, wave_s); GRID_BAR();
#pragma unroll
    for (int r2 = 0; r2 < REP_SCAN; ++r2) { ph_ret_scan(P, l, wave_s); GRID_BAR(); }
#pragma unroll
    for (int r2 = 0; r2 < REP_MIX3; ++r2) { ph_mix3(P, l, lds, wave_s); GRID_BAR(); } }
    { pg8::Gemm g{MIXB, (const bf16*)(wl + WL_OUT), M, D, D}; pg8::StaticOrder S; S.init(M, D, G, bx); pg8::EpiRes E{H, HBa, SS + (3 * l + 1) * M}; GEMM_PHASE(pg8::EpiRes); }
    GRID_BAR();
#pragma unroll
    for (int rep = 0; rep < REP_UP; ++rep) {
    { pg8::Gemm g{HBa, (const bf16*)(wl + WL_UP), M, FFW, D}; pg8::StaticOrder S; S.init(M, FFW, G, bx); pg8::EpiBf16<1> E{FFB, FFW, SS + (3 * l + 1) * M}; GEMM_PHASE(pg8::EpiBf16<1>); }
    GRID_BAR(); }
    { pg8::Gemm g{FFB, (const bf16*)(wl + WL_DOWN), M, D, FFW}; pg8::StaticOrder S; S.init(M, D, G, bx); pg8::EpiRes E{H, HBa, SS + (3 * l + 2) * M}; GEMM_PHASE(pg8::EpiRes); }
    GRID_BAR();
    { pg8::Gemm g{PBB + (size_t)l * M * PLE, (const bf16*)(wl + WL_PLE), M, D, PLE}; pg8::StaticOrder S; S.init(M, D, G, bx); pg8::EpiF32 E{PL}; GEMM_PHASE(pg8::EpiF32); }
    { pg8::Gemm g{HBa, (const bf16*)(wl + WL_GATE), M, D, D}; pg8::StaticOrder S; S.init(M, D, G, bx); pg8::EpiGate E{H, PL, HBb, SS + (3 * l + 2) * M, SS + (3 * l + 3) * M}; GEMM_PHASE(pg8::EpiGate); }
    GRID_BAR();
}
__global__ void __launch_bounds__(512, 2) k_mega(Params P) {
    extern __shared__ __attribute__((aligned(16))) unsigned char lds_raw[];
    LAS unsigned char* lds = (LAS unsigned char*)lds_raw;
    cg::grid_group grid = cg::this_grid();
    const int wave_s = __builtin_amdgcn_readfirstlane((int)(threadIdx.x >> 6));
    volatile LAS unsigned* misc = (volatile LAS unsigned*)(lds + LDS_MISC_OFF);
    if (threadIdx.x < 64) misc[threadIdx.x] = 0u;
    __syncthreads();
    XcdBarrier bar = xcd_barrier_post((unsigned*)(P.ws + WS_CTL + CTL_BAR), misc + 8); bar.w = wave_s;
#pragma unroll
    for (int rep = 0; rep < REP_PRO; ++rep) {
    ph_prologue(P, lds, wave_s);
    grid.sync(); }
    layer_body<0>(P, lds, bar, wave_s);
    layer_body<1>(P, lds, bar, wave_s);
    ph_final_norm(P, wave_s);
}

extern "C" void kernel_launch(void* const* d_in, const int* in_sizes, int n_in, void* d_out, int out_size, void* d_ws, size_t ws_size, hipStream_t stream) {
    static int grid_blocks = 0;
    if (!grid_blocks) {
        int dev = 0, cus = 0, per_cu = 0;
        (void)hipGetDevice(&dev);
        (void)hipDeviceGetAttribute(&cus, hipDeviceAttributeMultiprocessorCount, dev);
        (void)hipFuncSetAttribute((const void*)k_mega, hipFuncAttributeMaxDynamicSharedMemorySize, LDS_BYTES);
        (void)hipOccupancyMaxActiveBlocksPerMultiprocessor(&per_cu, (const void*)k_mega, 512, LDS_BYTES);
        if (per_cu != 1) fprintf(stderr, "kernel_launch: occupancy query says %d blocks per CU (expected 1)\n", per_cu);
        grid_blocks = cus;
        if (ws_size < WS_HB2 + 34 * MiB) fprintf(stderr, "kernel_launch: workspace too small: %zu\n", ws_size);
    }
    (void)hipMemsetAsync((unsigned char*)d_ws + WS_CTL, 0, CTL_ZERO_BYTES, stream);
    Params P{};
    const float** pp = (const float**)&P;
    for (int i = 0; i < 20; ++i) pp[i] = (const float*)d_in[i];
    P.out = (float*)d_out; P.ws = (unsigned char*)d_ws;
    void* args[] = {&P};
    hipError_t e = hipLaunchCooperativeKernel((const void*)k_mega, dim3(grid_blocks), dim3(512), args, LDS_BYTES, stream);
    if (e != hipSuccess) fprintf(stderr, "cooperative launch failed: %s (grid %d)\n", hipGetErrorString(e), grid_blocks);
}
```
